# Optimizing an MI355X kernel written in HIP

```python
import jax, jax.numpy as jnp
from jax import lax
import numpy as np

D_MODEL = 2048
BATCH = 2
SEQ = 8192
DEPTH = 1

HEAD_DIM = 128
N_KV_HEADS = 4
DILATED_PATTERNS = ((128, 1), (512, 4), (2048, 16))
N_PATTERNS = len(DILATED_PATTERNS)
N_Q_HEADS = N_KV_HEADS * N_PATTERNS
Q_WIDTH = N_Q_HEADS * HEAD_DIM
KV_WIDTH = N_KV_HEADS * HEAD_DIM
ATTN_OUT_WIDTH = N_KV_HEADS * HEAD_DIM
ROT_DIMS = HEAD_DIM // 4
ROPE_THETA = 500000.0
LRU_WIDTH = D_MODEL - ATTN_OUT_WIDTH
LRU_BLOCK_WIDTH = 128
LRU_BLOCKS = LRU_WIDTH // LRU_BLOCK_WIDTH
CONV_WIDTH = 4
LRU_C = 8.0
IN_PROJ_WIDTH = Q_WIDTH + 2 * KV_WIDTH + 2 * LRU_WIDTH
D_FF = 256 * ((8 * D_MODEL // 3 + 255) // 256)
D_PLE = 256
LN_EPS = 1e-5
DEEPNORM_ALPHA = (2.0 * DEPTH) ** 0.25
DEEPNORM_BETA = (8.0 * DEPTH) ** -0.25

kernel_name = 'hybrid_rglru_dilated_attn_macaron_deepnorm'


def layer_norm(x, g, b):
    xf = x.astype(jnp.float32)
    mu = xf.mean(-1, keepdims=True)
    var = jnp.square(xf - mu).mean(-1, keepdims=True)
    y = (xf - mu) * lax.rsqrt(var + LN_EPS)
    return (y * g.astype(jnp.float32) + b.astype(jnp.float32)).astype(x.dtype)


def swiglu(x, w_gate, w_up, w_down):
    return (jax.nn.silu(x @ w_gate) * (x @ w_up)) @ w_down


def partial_rotary(t, positions):
    half = ROT_DIMS // 2
    inv_freq = jnp.power(jnp.float32(ROPE_THETA), -jnp.arange(half, dtype=jnp.float32) * (2.0 / ROT_DIMS))
    ang = positions.astype(jnp.float32)[:, None, :, None] * inv_freq
    cos = jnp.cos(ang).astype(t.dtype)
    sin = jnp.sin(ang).astype(t.dtype)
    t1 = t[..., :half]
    t2 = t[..., half:ROT_DIMS]
    return jnp.concatenate([t1 * cos - t2 * sin, t2 * cos + t1 * sin, t[..., ROT_DIMS:]], axis=-1)


def dilated_window_attention(q, k, v, window, dilation):
    b, h, s, dh = q.shape
    span = window // dilation
    blk = span
    sub_len = s // dilation
    pad = (-sub_len) % blk
    nb = (sub_len + pad) // blk

    def to_blocks(t):
        t = t.reshape(b, h, sub_len, dilation, dh).swapaxes(2, 3)
        t = jnp.pad(t, ((0, 0), (0, 0), (0, 0), (0, pad), (0, 0)))
        return t.reshape(b, h, dilation, nb, blk, dh)

    def with_prev(t):
        prev = jnp.pad(t, ((0, 0), (0, 0), (0, 0), (1, 0), (0, 0), (0, 0)))[:, :, :, :-1]
        return jnp.concatenate([prev, t], axis=4)

    qb = to_blocks(q)
    kw = with_prev(to_blocks(k))
    vw = with_prev(to_blocks(v))
    scores = jnp.einsum('bhrnqe,bhrnke->bhrnqk', qb, kw,
                        preferred_element_type=jnp.float32) * (dh ** -0.5)
    qi = jnp.arange(blk)[:, None]
    ki = jnp.arange(2 * blk)[None, :]
    dist = qi + blk - ki
    band = (dist >= 0) & (dist <= span)
    not_first = (jnp.arange(nb) > 0)[:, None, None]
    mask = band[None] & (not_first | (ki >= blk)[None])
    scores = jnp.where(mask, scores, -jnp.inf)
    m = scores.max(-1, keepdims=True)
    e = jnp.exp(scores - m)
    den = e.sum(-1, keepdims=True)
    out = jnp.einsum('bhrnqk,bhrnke->bhrnqe', e, vw.astype(jnp.float32)) / den
    lse = (m + jnp.log(den))[..., 0]
    out = out.reshape(b, h, dilation, nb * blk, dh)[:, :, :, :sub_len].swapaxes(2, 3).reshape(b, h, s, dh)
    lse = lse.reshape(b, h, dilation, nb * blk)[..., :sub_len].swapaxes(2, 3).reshape(b, h, s)
    return out, lse


def rg_lru_branch(xb, yb, conv_w, conv_b, w_rgate, b_rgate, w_igate, b_igate, lam):
    b, s, c = xb.shape
    xc = lax.conv_general_dilated(xb, conv_w[:, None, :], window_strides=(1,),
                                  padding=((CONV_WIDTH - 1, 0),),
                                  dimension_numbers=('NWC', 'WIO', 'NWC'),
                                  feature_group_count=c) + conv_b
    xh = xc.reshape(b, s, LRU_BLOCKS, LRU_BLOCK_WIDTH)
    r = jax.nn.sigmoid(jnp.einsum('bsgi,gij->bsgj', xh, w_rgate).reshape(b, s, c) + b_rgate)
    i = jax.nn.sigmoid(jnp.einsum('bsgi,gij->bsgj', xh, w_igate).reshape(b, s, c) + b_igate)
    log_a = -LRU_C * jax.nn.softplus(-lam.astype(jnp.float32)) * r.astype(jnp.float32)
    a = jnp.exp(log_a)
    u = jnp.sqrt(-jnp.expm1(2.0 * log_a)) * (i * xc).astype(jnp.float32)

    def combine(left, right):
        a1, b1 = left
        a2, b2 = right
        return a1 * a2, a2 * b1 + b2

    _, hseq = lax.associative_scan(combine, (a, u), axis=1)
    return hseq.astype(xb.dtype) * jax.nn.gelu(yb)


def hybrid_mixer(h, positions, w_in, conv_w, conv_b, w_rgate, b_rgate, w_igate, b_igate, lam, w_out):
    b, s, _ = h.shape
    proj = h @ w_in
    q, k, v, xb, yb = jnp.split(proj, [Q_WIDTH, Q_WIDTH + KV_WIDTH, Q_WIDTH + 2 * KV_WIDTH,
                                       Q_WIDTH + 2 * KV_WIDTH + LRU_WIDTH], axis=-1)
    q = q.reshape(b, s, N_PATTERNS, N_KV_HEADS, HEAD_DIM).transpose(2, 0, 3, 1, 4)
    k = k.reshape(b, s, N_KV_HEADS, HEAD_DIM).transpose(0, 2, 1, 3)
    v = v.reshape(b, s, N_KV_HEADS, HEAD_DIM).transpose(0, 2, 1, 3)
    q = partial_rotary(q, positions)
    k = partial_rotary(k, positions)
    outs = []
    lses = []
    for g, (window, dilation) in enumerate(DILATED_PATTERNS):
        o, l = dilated_window_attention(q[g], k, v, window, dilation)
        outs.append(o)
        lses.append(l)
    weights = jax.nn.softmax(jnp.stack(lses), axis=0)
    attn = jnp.einsum('gbhs,gbhse->bshe', weights, jnp.stack(outs))
    attn = attn.reshape(b, s, ATTN_OUT_WIDTH).astype(h.dtype)
    rec = rg_lru_branch(xb, yb, conv_w, conv_b, w_rgate, b_rgate, w_igate, b_igate, lam)
    return jnp.concatenate([attn, rec], axis=-1) @ w_out


def setup_inputs(seed: int = 0) -> dict:
    key = jax.random.key(seed)
    ks = jax.random.split(key, 32)
    f32 = jnp.float32

    def nrm(k, shape, scale):
        return jax.random.normal(k, shape, f32) * scale

    x = jax.random.normal(ks[0], (BATCH, SEQ, D_MODEL), f32)
    p = jax.random.normal(ks[1], (DEPTH, BATCH, SEQ, D_PLE), f32)
    offset = jax.random.randint(ks[2], (BATCH, 1), 0, 1024, dtype=jnp.int32)
    positions = (jnp.arange(SEQ, dtype=jnp.int32)[None, :] + offset).astype(jnp.int32)
    a_pow = jax.random.uniform(ks[3], (DEPTH, LRU_WIDTH), f32, minval=0.9, maxval=0.999)
    a_base = a_pow ** (1.0 / LRU_C)
    lru_lambda = jnp.log(a_base) - jnp.log1p(-a_base)
    return {
        'x': x,
        'p': p,
        'positions': positions,
        'ffn1_w_gate': nrm(ks[4], (DEPTH, D_MODEL, D_FF), D_MODEL ** -0.5),
        'ffn1_w_up': nrm(ks[5], (DEPTH, D_MODEL, D_FF), D_MODEL ** -0.5),
        'ffn1_w_down': nrm(ks[6], (DEPTH, D_FF, D_MODEL), D_FF ** -0.5 * DEEPNORM_BETA),
        'ln1_g': 1.0 + nrm(ks[7], (DEPTH, D_MODEL), 0.02),
        'ln1_b': nrm(ks[8], (DEPTH, D_MODEL), 0.02),
        'w_in': nrm(ks[9], (DEPTH, D_MODEL, IN_PROJ_WIDTH), D_MODEL ** -0.5),
        'conv_w': nrm(ks[10], (DEPTH, CONV_WIDTH, LRU_WIDTH), CONV_WIDTH ** -0.5),
        'conv_b': nrm(ks[11], (DEPTH, LRU_WIDTH), 0.02),
        'w_rgate': nrm(ks[12], (DEPTH, LRU_BLOCKS, LRU_BLOCK_WIDTH, LRU_BLOCK_WIDTH), LRU_BLOCK_WIDTH ** -0.5),
        'b_rgate': nrm(ks[13], (DEPTH, LRU_WIDTH), 0.02),
        'w_igate': nrm(ks[14], (DEPTH, LRU_BLOCKS, LRU_BLOCK_WIDTH, LRU_BLOCK_WIDTH), LRU_BLOCK_WIDTH ** -0.5),
        'b_igate': nrm(ks[15], (DEPTH, LRU_WIDTH), 0.02),
        'lru_lambda': lru_lambda,
        'w_out': nrm(ks[16], (DEPTH, D_MODEL, D_MODEL), D_MODEL ** -0.5 * DEEPNORM_BETA),
        'ln2_g': 1.0 + nrm(ks[17], (DEPTH, D_MODEL), 0.02),
        'ln2_b': nrm(ks[18], (DEPTH, D_MODEL), 0.02),
        'ffn2_w_gate': nrm(ks[19], (DEPTH, D_MODEL, D_FF), D_MODEL ** -0.5),
        'ffn2_w_up': nrm(ks[20], (DEPTH, D_MODEL, D_FF), D_MODEL ** -0.5),
        'ffn2_w_down': nrm(ks[21], (DEPTH, D_FF, D_MODEL), D_FF ** -0.5 * DEEPNORM_BETA),
        'ln3_g': 1.0 + nrm(ks[22], (DEPTH, D_MODEL), 0.02),
        'ln3_b': nrm(ks[23], (DEPTH, D_MODEL), 0.02),
        'w_ple_proj': nrm(ks[24], (DEPTH, D_PLE, D_MODEL), D_PLE ** -0.5),
        'w_ple_gate': nrm(ks[25], (DEPTH, D_MODEL, D_MODEL), D_MODEL ** -0.5),
    }


def reference(x, p, positions, ffn1_w_gate, ffn1_w_up, ffn1_w_down, ln1_g, ln1_b,
              w_in, conv_w, conv_b, w_rgate, b_rgate, w_igate, b_igate, lru_lambda, w_out,
              ln2_g, ln2_b, ffn2_w_gate, ffn2_w_up, ffn2_w_down, ln3_g, ln3_b,
              w_ple_proj, w_ple_gate):
    for i in range(DEPTH):
        x = layer_norm(DEEPNORM_ALPHA * x + 0.5 * swiglu(x, ffn1_w_gate[i], ffn1_w_up[i], ffn1_w_down[i]),
                       ln1_g[i], ln1_b[i])
        mix = hybrid_mixer(x, positions, w_in[i], conv_w[i], conv_b[i], w_rgate[i], b_rgate[i],
                           w_igate[i], b_igate[i], lru_lambda[i], w_out[i])
        x = layer_norm(DEEPNORM_ALPHA * x + mix, ln2_g[i], ln2_b[i])
        x = layer_norm(DEEPNORM_ALPHA * x + 0.5 * swiglu(x, ffn2_w_gate[i], ffn2_w_up[i], ffn2_w_down[i]),
                       ln3_g[i], ln3_b[i])
        x = x + jax.nn.sigmoid(x @ w_ple_gate[i]) * (p[i] @ w_ple_proj[i])
    return x
```

```cpp
#include <hip/hip_runtime.h>
#include <hip/hip_cooperative_groups.h>
#include <cstdio>
#include <cstdint>
namespace cg = cooperative_groups;
namespace pg8 {
#define PG8_LAS __attribute__((address_space(3)))
typedef unsigned short bf16_t;
typedef short bf16x8 __attribute__((ext_vector_type(8)));
typedef float f32x4 __attribute__((ext_vector_type(4)));
typedef unsigned u32x4 __attribute__((ext_vector_type(4)));
constexpr int BM = 256, BK = 64, HALF = 128, HTB = HALF * BK * 2  , STAGE_BYTES = 8 * HTB, NXCD = 8, WGM = 8;

__host__ __device__ __forceinline__ int lds_byte(int r, int c) { const int st = (r >> 4) * 2 + (c >> 5), rr = r & 15, cc = c & 31, ob = rr * 64 + cc * 2; return st * 1024 + (ob ^ (((ob >> 9) & 1) << 5)); }
__host__ __device__ __forceinline__ void stage_rc(int b, int& R, int& C) { const int st = b / 1024, sb = b % 1024, swz = sb ^ (((sb >> 9) & 1) << 5); R = (st >> 1) * 16 + swz / 64; C = (st & 1) * 32 + (swz % 64) / 2; }
__host__ __device__ __forceinline__ int perm32(int rho) { const int n = rho >> 4, i = rho & 15; return 8 * (i >> 2) + 4 * n + (i & 3); }

struct Unit { int pm, pn; };
struct Gemm { const bf16_t* A; const bf16_t* Bt; int M, N, K, lda, apn2; };

struct StaticOrder {
    int nM, nN, nwg, G, c;
    __host__ __device__ void init(int M, int N, int G_, int c_) { nM = M / BM; nN = N / BM; nwg = nM * nN; G = G_; c = c_; }
    __host__ __device__ bool next(int i, Unit& u) const {
        const long L = (long)i * G + c; if (L >= nwg) return false;
        int wgid = (int)L; { const int q = nwg / NXCD, r = nwg % NXCD, xcd = wgid % NXCD, off = wgid / NXCD; wgid = (xcd < r ? xcd * (q + 1) : r * (q + 1) + (xcd - r) * q) + off; }
        const int nig = WGM * nN, gid = wgid / nig, fm = gid * WGM, gsz = (nM - fm) < WGM ? (nM - fm) : WGM;
        u.pm = fm + ((wgid % nig) % gsz); u.pn = (wgid % nig) / gsz; return true;
    }
    __device__ __forceinline__ void a_ready(const Unit&) const {}
    __device__ __forceinline__ void done(const Unit&) const {}
};

__device__ __forceinline__ unsigned cvt_pk_bf16(float lo, float hi) { unsigned r; asm volatile("v_cvt_pk_bf16_f32 %0, %1, %2" : "=v"(r) : "v"(lo), "v"(hi)); return r; }
typedef float f32x2 __attribute__((ext_vector_type(2)));

__device__ __forceinline__ float sigmoid_f(float v) { return __builtin_amdgcn_rcpf(1.0f + __builtin_amdgcn_exp2f(-1.4426950408889634f * v)); }
struct EpiBf16 {
    static constexpr bool PERM = true, AFTER_DRAIN = false;
    bf16_t* O; int ldc;
    __device__ __forceinline__ void operator()(const f32x4 (&acc)[2][2][4][2], const Unit& u, int wr, int wc, int fr, int fq) const {
        const int row0 = u.pm * BM + wr * 64 + fr, col0 = u.pn * BM + wc * 32 + 8 * fq;
#pragma unroll
        for (int ai = 0; ai < 2; ++ai)
#pragma unroll
            for (int m = 0; m < 4; ++m) { bf16_t* rowp = O + (size_t)(row0 + ai * HALF + m * 16) * ldc + col0;
#pragma unroll
                for (int bj = 0; bj < 2; ++bj) { const f32x4 v0 = acc[ai][bj][m][0], v1 = acc[ai][bj][m][1];
                    u32x4 w; w.x = cvt_pk_bf16(v0[0], v0[1]); w.y = cvt_pk_bf16(v0[2], v0[3]); w.z = cvt_pk_bf16(v1[0], v1[1]); w.w = cvt_pk_bf16(v1[2], v1[3]);
                    *(u32x4*)(rowp + bj * HALF) = w; } }
    }
};
struct EpiSwiglu {
    static constexpr bool PERM = true, AFTER_DRAIN = false;
    bf16_t* O; int ldc;
    __device__ __forceinline__ void operator()(const f32x4 (&acc)[2][2][4][2], const Unit& u, int wr, int wc, int fr, int fq) const {
        const int row0 = u.pm * BM + wr * 64 + fr, col0 = u.pn * HALF + wc * 32 + 8 * fq;
#pragma unroll
        for (int ai = 0; ai < 2; ++ai)
#pragma unroll
            for (int m = 0; m < 4; ++m) { bf16_t* rowp = O + (size_t)(row0 + ai * HALF + m * 16) * ldc + col0;
                float h[8];
#pragma unroll
                for (int n = 0; n < 2; ++n)
#pragma unroll
                    for (int j = 0; j < 4; ++j) { const float g = acc[ai][0][m][n][j], up = acc[ai][1][m][n][j]; h[4 * n + j] = g * sigmoid_f(g) * up; }
                u32x4 w; w.x = cvt_pk_bf16(h[0], h[1]); w.y = cvt_pk_bf16(h[2], h[3]); w.z = cvt_pk_bf16(h[4], h[5]); w.w = cvt_pk_bf16(h[6], h[7]);
                *(u32x4*)rowp = w; }
    }
};
struct EpiResF32 {
    static constexpr bool PERM = false, AFTER_DRAIN = false;
    const float* base; float* out; int ldc; float alpha, s;
    __device__ __forceinline__ void operator()(const f32x4 (&acc)[2][2][4][2], const Unit& u, int wr, int wc, int fr, int fq) const {
        const int row0 = u.pm * BM + wr * 64 + fr, col0 = u.pn * BM + wc * 32 + 4 * fq;
#pragma unroll
        for (int ai = 0; ai < 2; ++ai)
#pragma unroll
            for (int m = 0; m < 4; ++m) { const size_t off = (size_t)(row0 + ai * HALF + m * 16) * ldc + col0;
#pragma unroll
                for (int bj = 0; bj < 2; ++bj)
#pragma unroll
                    for (int n = 0; n < 2; ++n) { f32x4 v = acc[ai][bj][m][n] * s; if (base) v += *(const f32x4*)(base + off + bj * HALF + n * 16) * alpha; *(f32x4*)(out + off + bj * HALF + n * 16) = v; } }
    }
};
struct EpiPle {
    static constexpr bool PERM = false, AFTER_DRAIN = false;
    float* xo; const float* pp; int ldc;
    __device__ __forceinline__ void operator()(const f32x4 (&acc)[2][2][4][2], const Unit& u, int wr, int wc, int fr, int fq) const {
        const int row0 = u.pm * BM + wr * 64 + fr, col0 = u.pn * BM + wc * 32 + 4 * fq;
#pragma unroll
        for (int ai = 0; ai < 2; ++ai)
#pragma unroll
            for (int m = 0; m < 4; ++m) { const size_t off = (size_t)(row0 + ai * HALF + m * 16) * ldc + col0;
#pragma unroll
                for (int bj = 0; bj < 2; ++bj)
#pragma unroll
                    for (int n = 0; n < 2; ++n) { const size_t o2 = off + bj * HALF + n * 16; const f32x4 a = acc[ai][bj][m][n], x = *(const f32x4*)(xo + o2), p = *(const f32x4*)(pp + o2);
                        f32x4 r; r[0] = x[0] + sigmoid_f(a[0]) * p[0]; r[1] = x[1] + sigmoid_f(a[1]) * p[1]; r[2] = x[2] + sigmoid_f(a[2]) * p[2]; r[3] = x[3] + sigmoid_f(a[3]) * p[3];
                        *(f32x4*)(xo + o2) = r; } }
    }
};
struct EpiLru {
    static constexpr bool PERM = true, AFTER_DRAIN = false;
    const bf16_t* xc; bf16_t* la; bf16_t* uo; const float* br; const float* bi; const float* sp;
    __device__ __forceinline__ void operator()(const f32x4 (&acc)[2][2][4][2], const Unit& u, int wr, int wc, int fr, int fq) const {
        const int row0 = u.pm * BM + wr * 64 + fr, ch0 = u.pn * HALF + wc * 32 + 8 * fq;
#pragma unroll
        for (int ai = 0; ai < 2; ++ai)
#pragma unroll
            for (int m = 0; m < 4; ++m) { const size_t off = (size_t)(row0 + ai * HALF + m * 16) * 1536 + ch0;
                const u32x4 xv = *(const u32x4*)(xc + off); unsigned lw[4], uw[4];
#pragma unroll
                for (int n = 0; n < 2; ++n) { const f32x4 brv = *(const f32x4*)(br + ch0 + 4 * n), biv = *(const f32x4*)(bi + ch0 + 4 * n), spv = *(const f32x4*)(sp + ch0 + 4 * n); float lv[4], uv[4];
#pragma unroll
                    for (int j = 0; j < 4; ++j) { const unsigned xw = xv[2 * n + (j >> 1)]; const float x = __uint_as_float((j & 1) ? (xw & 0xffff0000u) : (xw << 16));
                        const float r = sigmoid_f(acc[ai][0][m][n][j] + brv[j]), ig = sigmoid_f(acc[ai][1][m][n][j] + biv[j]);
                        const float l = spv[j] * r; lv[j] = l; uv[j] = sqrtf(fmaxf(1.0f - __expf(2.0f * l), 0.f)) * (ig * x); }
                    lw[2 * n] = cvt_pk_bf16(lv[0], lv[1]); lw[2 * n + 1] = cvt_pk_bf16(lv[2], lv[3]); uw[2 * n] = cvt_pk_bf16(uv[0], uv[1]); uw[2 * n + 1] = cvt_pk_bf16(uv[2], uv[3]); }
                *(u32x4*)(la + off) = (u32x4){lw[0], lw[1], lw[2], lw[3]}; *(u32x4*)(uo + off) = (u32x4){uw[0], uw[1], uw[2], uw[3]};
                asm volatile("" ::: "memory"); }
    }
};

template <class Epi, class Sched, bool ALIGN_EPI = false, bool SP2 = false>
__device__ __forceinline__ void gemm_phase(PG8_LAS unsigned char* lds, const Gemm g, const Sched& S, const Epi& E) {
    const int tid = threadIdx.x, wid = __builtin_amdgcn_readfirstlane(tid >> 6), lane = tid & 63, wr = wid >> 2, wc = wid & 3, fr = lane & 15, fq = lane >> 4;
    const int K = g.K, nt = K / BK;
    unsigned voffA[2], voffB[2];
#pragma unroll
    for (int i = 0; i < 2; ++i) { int R, C; stage_rc(tid * 16 + i * 8192, R, C); const int Rb = Epi::PERM ? ((R & ~31) + perm32(R & 31)) : R;
        voffA[i] = (unsigned)(R * g.lda + C) * 2u; voffB[i] = (unsigned)(Rb * K + C) * 2u; }
    const size_t kstep = (size_t)(BK * 2);
    const size_t hstepA = (size_t)HALF * g.lda * 2, hstepB = (size_t)HALF * K * 2;
    const size_t tstepA = 2 * hstepA, tstepB = 2 * hstepB;
    const unsigned ldsw = (unsigned)wid * 1024u;
    const int aoff = lds_byte(wr * 64 + fr, fq * 8), boff = lds_byte(wc * 32 + fr, fq * 8);
#define PG8_SA(b, h) (((b) * 2 + (h)) * HTB)
#define PG8_SB(b, h) ((4 + (b) * 2 + (h)) * HTB)
#define PG8_STAGE(bufoff, gbase, voff) do { _Pragma("unroll") for (int _i = 0; _i < 2; ++_i) \
        __builtin_amdgcn_global_load_lds((const unsigned*)((const char*)(gbase) + (voff)[_i]), (PG8_LAS unsigned*)(lds + (bufoff) + ldsw + _i * 8192), 16, 0, 0); } while (0)
#define PG8_LDA(dst, b, h) do { _Pragma("unroll") for (int m = 0; m < 4; ++m) _Pragma("unroll") for (int k = 0; k < 2; ++k) dst[m][k] = *(const PG8_LAS bf16x8*)(lds + PG8_SA(b, h) + aoff + m * 2048 + k * 1024); } while (0)
#define PG8_LDB(dst, b, h) do { _Pragma("unroll") for (int n = 0; n < 2; ++n) _Pragma("unroll") for (int k = 0; k < 2; ++k) dst[n][k] = *(const PG8_LAS bf16x8*)(lds + PG8_SB(b, h) + boff + n * 2048 + k * 1024); } while (0)
#define PG8_MMA(ai, bj, At, Bt) do { __builtin_amdgcn_s_setprio(1); _Pragma("unroll") for (int m = 0; m < 4; ++m) _Pragma("unroll") for (int n = 0; n < 2; ++n) _Pragma("unroll") for (int k = 0; k < 2; ++k) \
        acc[ai][bj][m][n] = __builtin_amdgcn_mfma_f32_16x16x32_bf16(Bt[n][k], At[m][k], acc[ai][bj][m][n], 0, 0, 0); __builtin_amdgcn_s_setprio(0); } while (0)
#define PG8_WAIT_V(n) asm volatile("s_waitcnt vmcnt(" #n ")" ::: "memory")
#define PG8_WAIT_L(n) asm volatile("s_waitcnt lgkmcnt(" #n ")" ::: "memory")
#define PG8_BAR __builtin_amdgcn_s_barrier()
#define PG8_SCHED __builtin_amdgcn_sched_barrier(0)
    Unit cur, nxt; int ui = 0;
    if (!S.next(0, cur)) return;
    f32x4 acc[2][2][4][2];
#pragma unroll
    for (int a = 0; a < 2; ++a)
#pragma unroll
        for (int b = 0; b < 2; ++b)
#pragma unroll
            for (int m = 0; m < 4; ++m)
#pragma unroll
                for (int n = 0; n < 2; ++n) acc[a][b][m][n] = (f32x4){0.f, 0.f, 0.f, 0.f};
    bf16x8 At[4][2], B0[2][2], B1[2][2];
    const char* cA = (const char*)g.A + (size_t)cur.pm * tstepA + (size_t)(cur.pn >> 1) * g.apn2 * 2; const char* cB = (const char*)g.Bt + (size_t)cur.pn * tstepB;
    S.a_ready(cur);
    if constexpr (SP2) {
        PG8_STAGE(PG8_SB(0, 0), cB, voffB); PG8_STAGE(PG8_SB(0, 1), cB + hstepB, voffB); PG8_STAGE(PG8_SA(0, 0), cA, voffA); PG8_STAGE(PG8_SA(0, 1), cA + hstepA, voffA);
        if (wr == 1) PG8_BAR;
        PG8_WAIT_V(2); PG8_BAR;
        PG8_STAGE(PG8_SB(1, 0), cB + kstep, voffB); PG8_STAGE(PG8_SA(1, 0), cA + kstep, voffA); PG8_STAGE(PG8_SB(1, 1), cB + hstepB + kstep, voffB);
        PG8_WAIT_V(6); PG8_BAR;
    } else {
        PG8_STAGE(PG8_SB(0, 0), cB, voffB); PG8_STAGE(PG8_SA(0, 0), cA, voffA); PG8_STAGE(PG8_SB(0, 1), cB + hstepB, voffB); PG8_STAGE(PG8_SA(0, 1), cA + hstepA, voffA);
        if (wr == 1) PG8_BAR;
        PG8_WAIT_V(4); PG8_BAR;
        PG8_STAGE(PG8_SB(1, 0), cB + kstep, voffB); PG8_STAGE(PG8_SA(1, 0), cA + kstep, voffA); PG8_STAGE(PG8_SB(1, 1), cB + hstepB + kstep, voffB);
        PG8_WAIT_V(6); PG8_BAR;
    }
    for (;;) {
        const bool has_next = S.next(ui + 1, nxt);
        const char* nA = has_next ? (const char*)g.A + (size_t)nxt.pm * tstepA + (size_t)(nxt.pn >> 1) * g.apn2 * 2 : cA; const char* nB = has_next ? (const char*)g.Bt + (size_t)nxt.pn * tstepB : cB;
        for (int t = 0; t < nt; t += 2) {
            const bool last = (t == nt - 2);
            const char* a1 = cA + (size_t)(t + 1) * kstep;
            const char* a2 = last ? nA : cA + (size_t)(t + 2) * kstep; const char* b2 = last ? nB : cB + (size_t)(t + 2) * kstep;
            const char* a3 = a2 + kstep; const char* b3 = b2 + kstep;
            if (last && has_next) S.a_ready(nxt);
            if constexpr (SP2) {
            PG8_LDB(B0, 0, 0); PG8_LDB(B1, 0, 1); PG8_SCHED; PG8_LDA(At, 0, 0); PG8_STAGE(PG8_SA(1, 1), a1 + hstepA, voffA);
            PG8_WAIT_V(8); PG8_WAIT_L(0); PG8_BAR; PG8_MMA(0, 0, At, B0); PG8_MMA(0, 1, At, B1); PG8_BAR; PG8_SCHED;
            PG8_LDA(At, 0, 1); PG8_STAGE(PG8_SB(0, 0), b2, voffB); PG8_STAGE(PG8_SB(0, 1), b2 + hstepB, voffB); PG8_STAGE(PG8_SA(0, 0), a2, voffA);
            PG8_WAIT_V(8); PG8_WAIT_L(0); PG8_BAR; PG8_MMA(1, 0, At, B0); PG8_MMA(1, 1, At, B1); PG8_BAR; PG8_SCHED;
            PG8_LDB(B0, 1, 0); PG8_LDB(B1, 1, 1); PG8_SCHED; PG8_LDA(At, 1, 0); PG8_STAGE(PG8_SA(0, 1), a2 + hstepA, voffA);
            PG8_WAIT_V(8); PG8_WAIT_L(0); PG8_BAR; PG8_MMA(0, 0, At, B0); PG8_MMA(0, 1, At, B1); PG8_BAR; PG8_SCHED;
            PG8_LDA(At, 1, 1); PG8_STAGE(PG8_SB(1, 0), b3, voffB); PG8_STAGE(PG8_SB(1, 1), b3 + hstepB, voffB); PG8_STAGE(PG8_SA(1, 0), a3, voffA);
            PG8_WAIT_V(8); PG8_WAIT_L(0); PG8_BAR; PG8_MMA(1, 0, At, B0); PG8_MMA(1, 1, At, B1); PG8_BAR; PG8_SCHED;
            } else {
            PG8_LDB(B0, 0, 0); PG8_SCHED; PG8_LDA(At, 0, 0); PG8_STAGE(PG8_SA(1, 1), a1 + hstepA, voffA);
            PG8_WAIT_L(8); PG8_BAR; PG8_WAIT_L(0); PG8_MMA(0, 0, At, B0); PG8_BAR; PG8_SCHED;
            PG8_LDB(B1, 0, 1); PG8_STAGE(PG8_SB(0, 0), b2, voffB);
            PG8_BAR; PG8_WAIT_L(0); PG8_MMA(0, 1, At, B1); PG8_BAR;
            PG8_LDA(At, 0, 1); PG8_STAGE(PG8_SA(0, 0), a2, voffA);
            PG8_BAR; PG8_WAIT_L(0); PG8_MMA(1, 0, At, B0); PG8_BAR; PG8_SCHED;
            PG8_STAGE(PG8_SB(0, 1), b2 + hstepB, voffB);
            PG8_WAIT_V(6); PG8_BAR; PG8_MMA(1, 1, At, B1); PG8_BAR;
            PG8_LDB(B0, 1, 0); PG8_SCHED; PG8_LDA(At, 1, 0); PG8_STAGE(PG8_SA(0, 1), a2 + hstepA, voffA);
            PG8_WAIT_L(8); PG8_BAR; PG8_WAIT_L(0); PG8_MMA(0, 0, At, B0); PG8_BAR; PG8_SCHED;
            PG8_LDB(B1, 1, 1); PG8_STAGE(PG8_SB(1, 0), b3, voffB);
            PG8_BAR; PG8_WAIT_L(0); PG8_MMA(0, 1, At, B1); PG8_BAR;
            PG8_LDA(At, 1, 1); PG8_STAGE(PG8_SA(1, 0), a3, voffA);
            PG8_BAR; PG8_WAIT_L(0); PG8_MMA(1, 0, At, B0); PG8_BAR; PG8_SCHED;
            PG8_STAGE(PG8_SB(1, 1), b3 + hstepB, voffB);
            PG8_WAIT_V(6); PG8_BAR; PG8_MMA(1, 1, At, B1); PG8_BAR;
            }
        }
        if constexpr (ALIGN_EPI) { if (wr == 0) PG8_BAR; }
        if constexpr (!Epi::AFTER_DRAIN) { E(acc, cur, wr, wc, fr, fq); S.done(cur); }
        if (!has_next) break;
#pragma unroll
        for (int a = 0; a < 2; ++a)
#pragma unroll
            for (int b = 0; b < 2; ++b)
#pragma unroll
                for (int m = 0; m < 4; ++m)
#pragma unroll
                    for (int n = 0; n < 2; ++n) acc[a][b][m][n] = (f32x4){0.f, 0.f, 0.f, 0.f};
        cur = nxt; cA = nA; cB = nB; ++ui;
        if constexpr (ALIGN_EPI) { if (wr == 1) PG8_BAR; }
    }
    PG8_WAIT_V(0);
    if constexpr (!ALIGN_EPI) { if (wr == 0) PG8_BAR; }
    PG8_BAR;
    if constexpr (Epi::AFTER_DRAIN) { E.fused(acc, cur, wr, wc, fr, fq, lds, wid, lane); S.done(cur); }
#undef PG8_SA
#undef PG8_SB
#undef PG8_STAGE
#undef PG8_LDA
#undef PG8_LDB
#undef PG8_MMA
#undef PG8_WAIT_V
#undef PG8_WAIT_L
#undef PG8_BAR
#undef PG8_SCHED
}
}

constexpr int NWAVES = 8, NTHREADS = NWAVES * 64;
constexpr int SEQ = 8192, NB = 2, M = NB * SEQ, D = 2048, FF = 5632, NIN = 5632, LW = 1536;
constexpr int OFF_K = 1536, OFF_V = 2048, OFF_XB = 2560, OFF_YB = 4096;
constexpr float LN_EPS = 1e-5f, ALPHA = 1.189207115002721f;
constexpr size_t MiB = 1u << 20;
constexpr size_t WS_LSE = 1 * MiB, WS_SP = 2 * MiB;
constexpr size_t WS_WFGU = 4 * MiB, WS_WFD = 48 * MiB;
constexpr size_t WS_WIN = 70 * MiB, WS_WOUT = 92 * MiB, WS_WPG = 100 * MiB, WS_WPP = 108 * MiB, WS_WRG = 109 * MiB, WS_PB = 111 * MiB;
constexpr size_t WS_XB = 120 * MiB;
constexpr size_t WS_H = 184 * MiB;
constexpr size_t WS_XC = 360 * MiB, WS_LA = 408 * MiB, WS_U = 456 * MiB, WS_END = 504 * MiB;
constexpr int LDS_BYTES = 147456;

#define LAS __attribute__((address_space(3)))
typedef unsigned short bf16;
typedef unsigned v4u __attribute__((ext_vector_type(4)));
typedef unsigned v2u __attribute__((ext_vector_type(2)));
typedef float f32x4 __attribute__((ext_vector_type(4)));
#define LDS_WAIT() asm volatile("s_waitcnt lgkmcnt(0)" ::: "memory")
__device__ __forceinline__ unsigned f2bf(float f) { unsigned u = __builtin_bit_cast(unsigned, f); return (u + 0x7fffu + ((u >> 16) & 1u)) >> 16; }
__device__ __forceinline__ unsigned pk2(float lo, float hi) { return f2bf(lo) | (f2bf(hi) << 16); }
__device__ __forceinline__ float bflo(unsigned w) { return __uint_as_float(w << 16); }
__device__ __forceinline__ float bfhi(unsigned w) { return __uint_as_float(w & 0xffff0000u); }
__device__ __forceinline__ float bf1(bf16 h) { return __uint_as_float((unsigned)h << 16); }
__device__ __forceinline__ float wave_sum(float v) {
#pragma unroll
    for (int o = 1; o < 64; o <<= 1) v += __shfl_xor(v, o);
    return v;
}
__device__ __forceinline__ float wave_max(float v) {
#pragma unroll
    for (int o = 1; o < 64; o <<= 1) v = fmaxf(v, __shfl_xor(v, o));
    return v;
}
__device__ __forceinline__ float gelu_tanh(float x) {
    const float y = 0.7978845608028654f * (x + 0.044715f * x * x * x);
    const float t = 1.0f - 2.0f * __builtin_amdgcn_rcpf(1.0f + __expf(2.0f * y));
    return 0.5f * x * (1.0f + t);
}

struct Args { const float* in[26]; float* out; unsigned char* ws; int ph_lo, ph_hi; };

__device__ __forceinline__ void tr_item(const float* W, int N, int k0, int n0, bf16* WT, int drow0, int ldt, int dcol0, LAS float* scr, int lane) {
#pragma unroll 8
    for (int i = 0; i < 32; ++i) { const int kk = 2 * i + (lane >> 5); scr[kk * 33 + (lane & 31)] = W[(size_t)(k0 + kk) * N + n0 + (lane & 31)]; }
    LDS_WAIT(); asm volatile("" ::: "memory");
    const int c = lane & 7;
#pragma unroll
    for (int j = 0; j < 4; ++j) { const int n = (lane >> 3) + 8 * j; const LAS float* s = scr + (8 * c) * 33 + n;
        v4u o; o.x = pk2(s[0 * 33], s[1 * 33]); o.y = pk2(s[2 * 33], s[3 * 33]); o.z = pk2(s[4 * 33], s[5 * 33]); o.w = pk2(s[6 * 33], s[7 * 33]);
        *(v4u*)(WT + (size_t)(drow0 + n) * ldt + dcol0 + 8 * c) = o; }
    LDS_WAIT(); asm volatile("" ::: "memory");
}
__device__ __forceinline__ void tr_matrix_item(const float* W, int K, int N, bf16* WT, int mode, int item, LAS float* scr, int lane) {
    const int nblk = N / 32, kb = item / nblk, nb = item % nblk, k0 = 64 * kb, n0 = 32 * nb;
    int drow0 = n0; if (mode) drow0 = 256 * (n0 >> 7) + (n0 & 127) + (mode == 2 ? 128 : 0);
    tr_item(W, N, k0, n0, WT, drow0, K, k0, scr, lane);
}
constexpr int IT_FF = (D / 64) * (FF / 32);
__device__ __forceinline__ void convert_ffn(const float* wg, const float* wu, const float* wd, unsigned char* ws, LAS float* scr, int gw, int NGW, int lane) {
    for (int it = gw; it < 3 * IT_FF; it += NGW) {
        int r = it;
        if (r < IT_FF) { tr_matrix_item(wg, D, FF, (bf16*)(ws + WS_WFGU), 1, r, scr, lane); continue; } r -= IT_FF;
        if (r < IT_FF) { tr_matrix_item(wu, D, FF, (bf16*)(ws + WS_WFGU), 2, r, scr, lane); continue; } r -= IT_FF;
        tr_matrix_item(wd, FF, D, (bf16*)(ws + WS_WFD), 0, r, scr, lane);
    }
}
__device__ __forceinline__ void convert_rest(const Args& a, LAS float* scr, int gw, int NGW, int lane) {
    unsigned char* ws = a.ws;
    constexpr int I_IN = IT_FF, I_SQ = (D / 64) * (D / 32), I_PP = (256 / 64) * (D / 32), I_RG = 24 * 8;
    for (int it = gw; it < I_IN + 2 * I_SQ + I_PP + I_RG; it += NGW) {
        int r = it;
        if (r < I_IN) { tr_matrix_item(a.in[8], D, NIN, (bf16*)(ws + WS_WIN), 0, r, scr, lane); continue; } r -= I_IN;
        if (r < I_SQ) { tr_matrix_item(a.in[16], D, D, (bf16*)(ws + WS_WOUT), 0, r, scr, lane); continue; } r -= I_SQ;
        if (r < I_SQ) { tr_matrix_item(a.in[25], D, D, (bf16*)(ws + WS_WPG), 0, r, scr, lane); continue; } r -= I_SQ;
        if (r < I_PP) { tr_matrix_item(a.in[24], 256, D, (bf16*)(ws + WS_WPP), 0, r, scr, lane); continue; } r -= I_PP;
        { const int mi = r >> 3, sub = r & 7, gate = mi / 12, g = mi % 12, kb = sub >> 2, nb = sub & 3;
          const float* W = (gate ? a.in[13] : a.in[11]) + (size_t)g * 128 * 128; bf16* WT = (bf16*)(ws + WS_WRG);
          const int drow0 = 256 * g + 128 * gate + 32 * nb;
          tr_item(W, 128, 64 * kb, 32 * nb, WT, drow0, 256, 128 * (g & 1) + 64 * kb, scr, lane);
          const int c = lane & 7;
#pragma unroll
          for (int j = 0; j < 4; ++j) { const int n = (lane >> 3) + 8 * j; *(v4u*)(WT + (size_t)(drow0 + n) * 256 + 128 * ((g & 1) ^ 1) + 64 * kb + 8 * c) = (v4u){0u, 0u, 0u, 0u}; } }
    }
}
__device__ __forceinline__ void cvt_rows(const float* src, bf16* dst, size_t n, int gtid, int gthreads) {
    for (size_t i = (size_t)gtid * 8; i < n; i += (size_t)gthreads * 8) {
        const f32x4 a = *(const f32x4*)(src + i), b = *(const f32x4*)(src + i + 4);
        *(v4u*)(dst + i) = (v4u){pk2(a[0], a[1]), pk2(a[2], a[3]), pk2(b[0], b[1]), pk2(b[2], b[3])};
    }
}
__device__ __forceinline__ void ln_rows(float* z, bf16* xb, const float* g, const float* b, int gw, int NGW, int lane) {
    for (int m = gw; m < M; m += NGW) {
        f32x4* zr = (f32x4*)(z + (size_t)m * D) + lane; f32x4 v[8]; float s = 0.f;
#pragma unroll
        for (int j = 0; j < 8; ++j) { v[j] = zr[64 * j]; s += (v[j][0] + v[j][1]) + (v[j][2] + v[j][3]); }
        const float mean = wave_sum(s) * (1.f / D); float s2 = 0.f;
#pragma unroll
        for (int j = 0; j < 8; ++j) { v[j] = v[j] - mean; s2 += (v[j][0] * v[j][0] + v[j][1] * v[j][1]) + (v[j][2] * v[j][2] + v[j][3] * v[j][3]); }
        const float rstd = 1.f / sqrtf(wave_sum(s2) * (1.f / D) + LN_EPS);
        v2u* o8 = (v2u*)(xb + (size_t)m * D) + lane;
#pragma unroll
        for (int j = 0; j < 8; ++j) { const f32x4 gg = *((const f32x4*)g + lane + 64 * j), bb = *((const f32x4*)b + lane + 64 * j);
            const f32x4 y = v[j] * rstd * gg + bb; zr[64 * j] = y; o8[64 * j] = (v2u){pk2(y[0], y[1]), pk2(y[2], y[3])}; }
    }
}
__device__ __forceinline__ void rotary_rows(bf16* proj, const int* positions, int gtid, int gthreads) {
    constexpr float INVF[16] = {1.000000000e+00f, 4.403665960e-01f, 1.939227432e-01f, 8.539710194e-02f, 3.760603070e-02f, 1.656043902e-02f, 7.292664610e-03f, 3.211445874e-03f,
                                1.414213562e-03f, 6.227723788e-04f, 2.742481884e-04f, 1.207697351e-04f, 5.318296098e-05f, 2.341999971e-05f, 1.031338616e-05f, 4.541670478e-06f};
    for (int it = gtid; it < M * 16; it += gthreads) {
        const int m = it >> 4, hh = it & 15; v4u* p = (v4u*)(proj + (size_t)m * NIN + hh * 128);
        const v4u a0 = p[0], a1 = p[1], b0 = p[2], b1 = p[3]; const float pos = (float)positions[m];
        float t1[16], t2[16];
#pragma unroll
        for (int i = 0; i < 4; ++i) { t1[2 * i] = bflo(a0[i]); t1[2 * i + 1] = bfhi(a0[i]); t1[8 + 2 * i] = bflo(a1[i]); t1[8 + 2 * i + 1] = bfhi(a1[i]);
                                      t2[2 * i] = bflo(b0[i]); t2[2 * i + 1] = bfhi(b0[i]); t2[8 + 2 * i] = bflo(b1[i]); t2[8 + 2 * i + 1] = bfhi(b1[i]); }
        float o1[16], o2[16];
#pragma unroll
        for (int i = 0; i < 16; ++i) { const float ang = pos * INVF[i]; const float c = cosf(ang), s = sinf(ang); o1[i] = t1[i] * c - t2[i] * s; o2[i] = t2[i] * c + t1[i] * s; }
        p[0] = (v4u){pk2(o1[0], o1[1]), pk2(o1[2], o1[3]), pk2(o1[4], o1[5]), pk2(o1[6], o1[7])};
        p[1] = (v4u){pk2(o1[8], o1[9]), pk2(o1[10], o1[11]), pk2(o1[12], o1[13]), pk2(o1[14], o1[15])};
        p[2] = (v4u){pk2(o2[0], o2[1]), pk2(o2[2], o2[3]), pk2(o2[4], o2[5]), pk2(o2[6], o2[7])};
        p[3] = (v4u){pk2(o2[8], o2[9]), pk2(o2[10], o2[11]), pk2(o2[12], o2[13]), pk2(o2[14], o2[15])};
    }
}
__device__ __forceinline__ void conv_rows(const bf16* proj, const float* cw, const float* cb, bf16* xc, int gtid, int gthreads) {
    for (int it = gtid; it < M * (LW / 8); it += gthreads) {
        const int m = it / (LW / 8), c8 = (it % (LW / 8)) * 8, t = m & (SEQ - 1);
        float acc[8];
        { const f32x4 b0 = *(const f32x4*)(cb + c8), b1 = *(const f32x4*)(cb + c8 + 4); acc[0] = b0[0]; acc[1] = b0[1]; acc[2] = b0[2]; acc[3] = b0[3]; acc[4] = b1[0]; acc[5] = b1[1]; acc[6] = b1[2]; acc[7] = b1[3]; }
#pragma unroll
        for (int j = 0; j < 4; ++j) { if (t - 3 + j >= 0) {
            const v4u xv = *(const v4u*)(proj + (size_t)(m - 3 + j) * NIN + OFF_XB + c8);
            const f32x4 w0 = *(const f32x4*)(cw + j * LW + c8), w1 = *(const f32x4*)(cw + j * LW + c8 + 4);
            acc[0] += w0[0] * bflo(xv[0]); acc[1] += w0[1] * bfhi(xv[0]); acc[2] += w0[2] * bflo(xv[1]); acc[3] += w0[3] * bfhi(xv[1]);
            acc[4] += w1[0] * bflo(xv[2]); acc[5] += w1[1] * bfhi(xv[2]); acc[6] += w1[2] * bflo(xv[3]); acc[7] += w1[3] * bfhi(xv[3]); } }
        *(v4u*)(xc + (size_t)m * LW + c8) = (v4u){pk2(acc[0], acc[1]), pk2(acc[2], acc[3]), pk2(acc[4], acc[5]), pk2(acc[6], acc[7])};
    }
}
__device__ __forceinline__ void attn_scalar(bf16* proj, float* lse, int gw, int NGW, int lane) {
    const int total = M * 12, per = (total + NGW - 1) / NGW, Tend = min(total, (gw + 1) * per);
    for (int T = gw * per; T < Tend; ++T) {
        const int hq = T / M, m = T % M, t = m & (SEQ - 1), g = hq >> 2, h = hq & 3, dsh = 2 * g;
        bf16* qp = proj + (size_t)m * NIN + hq * 128;
        const bf16* kb = proj + OFF_K + h * 128; const bf16* vb = proj + OFF_V + h * 128;
        const int jmax = min(128, t >> dsh);
        v4u qv[16];
#pragma unroll
        for (int c = 0; c < 16; ++c) qv[c] = *(const v4u*)(qp + 8 * c);
        float sc[3];
#pragma unroll
        for (int ps = 0; ps < 3; ++ps) {
            const int j = lane + 64 * ps; float s = -INFINITY;
            if (j <= jmax && (ps < 2 || lane == 0)) {
                const bf16* kr = kb + (size_t)(m - (j << dsh)) * NIN; float d0 = 0.f, d1 = 0.f;
#pragma unroll
                for (int c = 0; c < 16; ++c) { const v4u kv = *(const v4u*)(kr + 8 * c);
#pragma unroll
                    for (int e = 0; e < 4; ++e) { d0 += bflo(qv[c][e]) * bflo(kv[e]); d1 += bfhi(qv[c][e]) * bfhi(kv[e]); } }
                s = (d0 + d1) * 0.08838834764831845f;
            }
            sc[ps] = s;
        }
        const float mx = wave_max(fmaxf(fmaxf(sc[0], sc[1]), sc[2]));
        const float e0 = __expf(sc[0] - mx), e1 = __expf(sc[1] - mx), e2 = __expf(sc[2] - mx);
        const float den = wave_sum(e0 + e1 + e2);
        float a0 = 0.f, a1 = 0.f;
        for (int j = 0; j <= jmax; ++j) {
            const float src = (j < 64) ? e0 : ((j < 128) ? e1 : e2);
            const float p = __uint_as_float(__builtin_amdgcn_readlane(__float_as_uint(src), j & 63));
            const unsigned vv = *(const unsigned*)(vb + (size_t)(m - (j << dsh)) * NIN + 2 * lane);
            a0 += p * bflo(vv); a1 += p * bfhi(vv);
        }
        const float inv = 1.0f / den;
        *(unsigned*)(qp + 2 * lane) = pk2(a0 * inv, a1 * inv);
        if (lane == 0) lse[(size_t)m * 12 + hq] = mx + __logf(den);
    }
}
__device__ __forceinline__ void merge_rows(const bf16* proj, const float* lse, bf16* cat, int gtid, int gthreads) {
    for (int it = gtid; it < M * 64; it += gthreads) {
        const int m = it >> 6, h = (it >> 4) & 3, c8 = (it & 15) * 8;
        const float l0 = lse[(size_t)m * 12 + h], l1 = lse[(size_t)m * 12 + 4 + h], l2 = lse[(size_t)m * 12 + 8 + h];
        const float mx = fmaxf(fmaxf(l0, l1), l2); float w0 = __expf(l0 - mx), w1 = __expf(l1 - mx), w2 = __expf(l2 - mx);
        const float inv = 1.0f / (w0 + w1 + w2); w0 *= inv; w1 *= inv; w2 *= inv;
        const bf16* qp = proj + (size_t)m * NIN + h * 128 + c8;
        const v4u o0 = *(const v4u*)qp, o1 = *(const v4u*)(qp + 512), o2 = *(const v4u*)(qp + 1024);
        v4u r;
#pragma unroll
        for (int e = 0; e < 4; ++e) r[e] = pk2(w0 * bflo(o0[e]) + w1 * bflo(o1[e]) + w2 * bflo(o2[e]), w0 * bfhi(o0[e]) + w1 * bfhi(o1[e]) + w2 * bfhi(o2[e]));
        *(v4u*)(cat + (size_t)m * D + h * 128 + c8) = r;
    }
}
__device__ __forceinline__ void scan_items(const bf16* la, const bf16* uu, const bf16* proj, bf16* cat, LAS float* sm, int G, int bid, int tid) {
    const int c = tid & 15, s = tid >> 4;
    for (int item = bid; item < NB * (LW / 16); item += G) {
        const int b = item / (LW / 16), ch = (item % (LW / 16)) * 16 + c;
        const size_t m0 = (size_t)b * SEQ + (size_t)s * 256;
        float A = 0.f, H = 0.f;
#pragma unroll 8
        for (int t = 0; t < 256; ++t) { const float l = bf1(la[(m0 + t) * LW + ch]), u = bf1(uu[(m0 + t) * LW + ch]); H = __expf(l) * H + u; A += l; }
        sm[s * 16 + c] = A; sm[512 + s * 16 + c] = H;
        __syncthreads();
        float h = 0.f;
        for (int sp = 0; sp < s; ++sp) h = __expf(sm[sp * 16 + c]) * h + sm[512 + sp * 16 + c];
#pragma unroll 8
        for (int t = 0; t < 256; ++t) { const float l = bf1(la[(m0 + t) * LW + ch]), u = bf1(uu[(m0 + t) * LW + ch]); h = __expf(l) * h + u;
            const float y = bf1(proj[(m0 + t) * NIN + OFF_YB + ch]); cat[(m0 + t) * D + 512 + ch] = (bf16)f2bf(h * gelu_tanh(y)); }
        __syncthreads();
    }
}

#ifndef MK_N_LAUNCHES
#define MK_N_LAUNCHES 1
#endif
constexpr int NPHASES = 14;
__global__ void __launch_bounds__(NTHREADS, 2) fwd_kernel(Args a) {
    extern __shared__ __attribute__((aligned(16))) unsigned char lds_raw[];
    LAS unsigned char* lds = (LAS unsigned char*)lds_raw;
    const int tid = threadIdx.x, lane = tid & 63, wave = __builtin_amdgcn_readfirstlane(tid >> 6);
    const int G = gridDim.x, bid = blockIdx.x, gw = bid * NWAVES + wave, NGW = G * NWAVES, gtid = bid * NTHREADS + tid, gthreads = G * NTHREADS;
    LAS float* scr = (LAS float*)(lds + wave * 16384);
    unsigned char* ws = a.ws;
    bf16* XB = (bf16*)(ws + WS_XB); bf16* HB = (bf16*)(ws + WS_H); float* PP = (float*)(ws + WS_H);
    bf16* XC = (bf16*)(ws + WS_XC); bf16* LA = (bf16*)(ws + WS_LA); bf16* UU = (bf16*)(ws + WS_U); float* LSE = (float*)(ws + WS_LSE);
    const float* x = a.in[0]; float* out = a.out;
    const int lo = a.ph_lo, hi = a.ph_hi;
#ifndef PHASE_MASK
#define PHASE_MASK 0xffff
#endif
#define IN(k) (((PHASE_MASK >> (k)) & 1) && lo <= (k) && (k) < hi)
#define SEAM(k) do { if (IN((k) + 1)) cg::this_grid().sync(); } while (0)
    typedef pg8::StaticOrder SO;
    if (IN(0)) {
        convert_ffn(a.in[3], a.in[4], a.in[5], ws, scr, gw, NGW, lane);
        convert_rest(a, scr, gw, NGW, lane);
        cvt_rows(x, XB, (size_t)M * D, gtid, gthreads);
        cvt_rows(a.in[1], (bf16*)(ws + WS_PB), (size_t)M * 256, gtid, gthreads);
        if (gtid < LW) ((float*)(ws + WS_SP))[gtid] = -8.0f * log1pf(expf(-a.in[15][gtid]));
        __syncthreads(); SEAM(0);
    }
    if (IN(1)) {
        pg8::Gemm g{XB, (const bf16*)(ws + WS_WFGU), M, 2 * FF, D, D, 0}; SO S; S.init(M, 2 * FF, G, bid);
        pg8::EpiSwiglu E{HB, FF};
        pg8::gemm_phase<pg8::EpiSwiglu, SO, true, true>(lds, g, S, E);
        SEAM(1);
    }
    if (IN(2)) {
        pg8::Gemm g{HB, (const bf16*)(ws + WS_WFD), M, D, FF, FF, 0}; SO S; S.init(M, D, G, bid);
        pg8::EpiResF32 E{x, out, D, ALPHA, 0.5f};
        pg8::gemm_phase<pg8::EpiResF32, SO, true, true>(lds, g, S, E);
        SEAM(2);
    }
    if (IN(3)) {
        ln_rows(out, XB, a.in[6], a.in[7], gw, NGW, lane);
        convert_ffn(a.in[19], a.in[20], a.in[21], ws, scr, gw, NGW, lane);
        __syncthreads(); SEAM(3);
    }
    if (IN(4)) {
        pg8::Gemm g{XB, (const bf16*)(ws + WS_WIN), M, NIN, D, D, 0}; SO S; S.init(M, NIN, G, bid);
        pg8::EpiBf16 E{HB, NIN};
        pg8::gemm_phase<pg8::EpiBf16, SO, true, true>(lds, g, S, E);
        SEAM(4);
    }
    if (IN(5)) {
        rotary_rows(HB, (const int*)a.in[2], gtid, gthreads);
        conv_rows(HB, a.in[9], a.in[10], XC, gtid, gthreads);
        SEAM(5);
    }
    if (IN(6)) {
        pg8::Gemm g{XC, (const bf16*)(ws + WS_WRG), M, 3072, 256, LW, 256}; SO S; S.init(M, 3072, G, bid);
        pg8::EpiLru E{XC, LA, UU, a.in[12], a.in[14], (const float*)(ws + WS_SP)};
        pg8::gemm_phase<pg8::EpiLru, SO, true, true>(lds, g, S, E);
        attn_scalar(HB, LSE, gw, NGW, lane);
        SEAM(6);
    }
    if (IN(7)) {
        __syncthreads();
        scan_items(LA, UU, HB, XB, (LAS float*)lds, G, bid, tid);
        merge_rows(HB, LSE, XB, gtid, gthreads);
        SEAM(7);
    }
    if (IN(8)) {
        pg8::Gemm g{XB, (const bf16*)(ws + WS_WOUT), M, D, D, D, 0}; SO S; S.init(M, D, G, bid);
        pg8::EpiResF32 E{out, out, D, ALPHA, 1.0f};
        pg8::gemm_phase<pg8::EpiResF32, SO, true, true>(lds, g, S, E);
        SEAM(8);
    }
    if (IN(9)) { ln_rows(out, XB, a.in[17], a.in[18], gw, NGW, lane); SEAM(9); }
    if (IN(10)) {
        pg8::Gemm g{XB, (const bf16*)(ws + WS_WFGU), M, 2 * FF, D, D, 0}; SO S; S.init(M, 2 * FF, G, bid);
        pg8::EpiSwiglu E{HB, FF};
        pg8::gemm_phase<pg8::EpiSwiglu, SO, true, true>(lds, g, S, E);
        SEAM(10);
    }
    if (IN(11)) {
        pg8::Gemm g{HB, (const bf16*)(ws + WS_WFD), M, D, FF, FF, 0}; SO S; S.init(M, D, G, bid);
        pg8::EpiResF32 E{out, out, D, ALPHA, 0.5f};
        pg8::gemm_phase<pg8::EpiResF32, SO, true, true>(lds, g, S, E);
        SEAM(11);
    }
    if (IN(12)) {
        ln_rows(out, XB, a.in[22], a.in[23], gw, NGW, lane);
        __syncthreads();
        pg8::Gemm g{(const bf16*)(ws + WS_PB), (const bf16*)(ws + WS_WPP), M, D, 256, 256, 0}; SO S; S.init(M, D, G, bid);
        pg8::EpiResF32 E{nullptr, PP, D, 0.f, 1.0f};
        pg8::gemm_phase<pg8::EpiResF32, SO, true, true>(lds, g, S, E);
        SEAM(12);
    }
    if (IN(13)) {
        pg8::Gemm g{XB, (const bf16*)(ws + WS_WPG), M, D, D, D, 0}; SO S; S.init(M, D, G, bid);
        pg8::EpiPle E{out, PP, D};
        pg8::gemm_phase<pg8::EpiPle, SO, true, true>(lds, g, S, E);
    }
#undef IN
#undef SEAM
}

extern "C" void kernel_launch(void* const* d_in, const int* in_sizes, int n_in, void* d_out, int out_size, void* d_ws, size_t ws_size, hipStream_t stream) {
    static int grid = 0;
    if (grid == 0) {
        if (n_in != 26 || out_size != M * D || ws_size < WS_END) { fprintf(stderr, "kernel_launch: unexpected problem (n_in %d, out %d, ws %zu)\n", n_in, out_size, ws_size); grid = -1; return; }
        int dev = 0, cus = 0, per_cu = 0;
        (void)hipGetDevice(&dev); (void)hipDeviceGetAttribute(&cus, hipDeviceAttributeMultiprocessorCount, dev);
        if (hipFuncSetAttribute((const void*)fwd_kernel, hipFuncAttributeMaxDynamicSharedMemorySize, LDS_BYTES) != hipSuccess) { fprintf(stderr, "kernel_launch: hipFuncSetAttribute failed\n"); grid = -1; return; }
        if (hipOccupancyMaxActiveBlocksPerMultiprocessor(&per_cu, (const void*)fwd_kernel, NTHREADS, LDS_BYTES) != hipSuccess || per_cu < 1) { fprintf(stderr, "kernel_launch: occupancy query says %d\n", per_cu); per_cu = 1; }
        (void)hipGetLastError();
        grid = cus * 1;
    }
    if (grid < 0) return;
    Args a{};
    for (int i = 0; i < 26; ++i) a.in[i] = (const float*)d_in[i];
    a.out = (float*)d_out; a.ws = (unsigned char*)d_ws;
#if MK_N_LAUNCHES == 1
    a.ph_lo = 0; a.ph_hi = NPHASES;
    void* args[] = {&a};
    hipError_t e = hipLaunchCooperativeKernel((const void*)fwd_kernel, dim3(grid), dim3(NTHREADS), args, LDS_BYTES, stream);
    if (e != hipSuccess) fprintf(stderr, "cooperative launch failed: %s (grid %d)\n", hipGetErrorString(e), grid);
#else
    for (int p = 0; p < NPHASES; ++p) { a.ph_lo = p; a.ph_hi = p + 1; hipLaunchKernelGGL(fwd_kernel, dim3(grid), dim3(NTHREADS), LDS_BYTES, stream, a); }
#endif
}
```

```cpp
#include <hip/hip_runtime.h>
#include <hip/hip_cooperative_groups.h>
#include <cstdio>
#include <cstdint>
namespace cg = cooperative_groups;
namespace pg8 {
#define PG8_LAS __attribute__((address_space(3)))
typedef unsigned short bf16_t;
typedef short bf16x8 __attribute__((ext_vector_type(8)));
typedef float f32x4 __attribute__((ext_vector_type(4)));
typedef unsigned u32x4 __attribute__((ext_vector_type(4)));
constexpr int BM = 256, BK = 64, HALF = 128, HTB = HALF * BK * 2  , STAGE_BYTES = 8 * HTB, NXCD = 8, WGM = 8;

__host__ __device__ __forceinline__ int lds_byte(int r, int c) { const int st = (r >> 4) * 2 + (c >> 5), rr = r & 15, cc = c & 31, ob = rr * 64 + cc * 2; return st * 1024 + (ob ^ (((ob >> 9) & 1) << 5)); }
__host__ __device__ __forceinline__ void stage_rc(int b, int& R, int& C) { const int st = b / 1024, sb = b % 1024, swz = sb ^ (((sb >> 9) & 1) << 5); R = (st >> 1) * 16 + swz / 64; C = (st & 1) * 32 + (swz % 64) / 2; }
__host__ __device__ __forceinline__ int perm32(int rho) { const int n = rho >> 4, i = rho & 15; return 8 * (i >> 2) + 4 * n + (i & 3); }

struct Unit { int pm, pn; };
struct Gemm { const bf16_t* A; const bf16_t* Bt; int M, N, K, lda, apn2; };

struct StaticOrder {
    int nM, nN, nwg, G, c;
    __host__ __device__ void init(int M, int N, int G_, int c_) { nM = M / BM; nN = N / BM; nwg = nM * nN; G = G_; c = c_; }
    __host__ __device__ bool next(int i, Unit& u) const {
        const long L = (long)i * G + c; if (L >= nwg) return false;
        int wgid = (int)L; { const int q = nwg / NXCD, r = nwg % NXCD, xcd = wgid % NXCD, off = wgid / NXCD; wgid = (xcd < r ? xcd * (q + 1) : r * (q + 1) + (xcd - r) * q) + off; }
        const int nig = WGM * nN, gid = wgid / nig, fm = gid * WGM, gsz = (nM - fm) < WGM ? (nM - fm) : WGM;
        u.pm = fm + ((wgid % nig) % gsz); u.pn = (wgid % nig) / gsz; return true;
    }
    __device__ __forceinline__ void a_ready(const Unit&) const {}
    __device__ __forceinline__ void done(const Unit&) const {}
};

__device__ __forceinline__ unsigned cvt_pk_bf16(float lo, float hi) { unsigned r; asm volatile("v_cvt_pk_bf16_f32 %0, %1, %2" : "=v"(r) : "v"(lo), "v"(hi)); return r; }
typedef float f32x2 __attribute__((ext_vector_type(2)));

__device__ __forceinline__ float sigmoid_f(float v) { return __builtin_amdgcn_rcpf(1.0f + __builtin_amdgcn_exp2f(-1.4426950408889634f * v)); }
struct EpiBf16 {
    static constexpr bool PERM = true, AFTER_DRAIN = false;
    bf16_t* O; int ldc;
    __device__ __forceinline__ void operator()(const f32x4 (&acc)[2][2][4][2], const Unit& u, int wr, int wc, int fr, int fq) const {
        const int row0 = u.pm * BM + wr * 64 + fr, col0 = u.pn * BM + wc * 32 + 8 * fq;
#pragma unroll
        for (int ai = 0; ai < 2; ++ai)
#pragma unroll
            for (int m = 0; m < 4; ++m) { bf16_t* rowp = O + (size_t)(row0 + ai * HALF + m * 16) * ldc + col0;
#pragma unroll
                for (int bj = 0; bj < 2; ++bj) { const f32x4 v0 = acc[ai][bj][m][0], v1 = acc[ai][bj][m][1];
                    u32x4 w; w.x = cvt_pk_bf16(v0[0], v0[1]); w.y = cvt_pk_bf16(v0[2], v0[3]); w.z = cvt_pk_bf16(v1[0], v1[1]); w.w = cvt_pk_bf16(v1[2], v1[3]);
                    *(u32x4*)(rowp + bj * HALF) = w; } }
    }
};
struct EpiSwiglu {
    static constexpr bool PERM = true, AFTER_DRAIN = false;
    bf16_t* O; int ldc;
    __device__ __forceinline__ void operator()(const f32x4 (&acc)[2][2][4][2], const Unit& u, int wr, int wc, int fr, int fq) const {
        const int row0 = u.pm * BM + wr * 64 + fr, col0 = u.pn * HALF + wc * 32 + 8 * fq;
#pragma unroll
        for (int ai = 0; ai < 2; ++ai)
#pragma unroll
            for (int m = 0; m < 4; ++m) { bf16_t* rowp = O + (size_t)(row0 + ai * HALF + m * 16) * ldc + col0;
                float h[8];
#pragma unroll
                for (int n = 0; n < 2; ++n)
#pragma unroll
                    for (int j = 0; j < 4; ++j) { const float g = acc[ai][0][m][n][j], up = acc[ai][1][m][n][j]; h[4 * n + j] = g * sigmoid_f(g) * up; }
                u32x4 w; w.x = cvt_pk_bf16(h[0], h[1]); w.y = cvt_pk_bf16(h[2], h[3]); w.z = cvt_pk_bf16(h[4], h[5]); w.w = cvt_pk_bf16(h[6], h[7]);
                *(u32x4*)rowp = w; }
    }
};
struct EpiResF32 {
    static constexpr bool PERM = false, AFTER_DRAIN = false;
    const float* base; float* out; int ldc; float alpha, s;
    __device__ __forceinline__ void operator()(const f32x4 (&acc)[2][2][4][2], const Unit& u, int wr, int wc, int fr, int fq) const {
        const int row0 = u.pm * BM + wr * 64 + fr, col0 = u.pn * BM + wc * 32 + 4 * fq;
#pragma unroll
        for (int ai = 0; ai < 2; ++ai)
#pragma unroll
            for (int m = 0; m < 4; ++m) { const size_t off = (size_t)(row0 + ai * HALF + m * 16) * ldc + col0;
#pragma unroll
                for (int bj = 0; bj < 2; ++bj)
#pragma unroll
                    for (int n = 0; n < 2; ++n) { f32x4 v = acc[ai][bj][m][n] * s; if (base) v += *(const f32x4*)(base + off + bj * HALF + n * 16) * alpha; *(f32x4*)(out + off + bj * HALF + n * 16) = v; } }
    }
};
struct EpiPle {
    static constexpr bool PERM = false, AFTER_DRAIN = false;
    float* xo; const float* pp; int ldc;
    __device__ __forceinline__ void operator()(const f32x4 (&acc)[2][2][4][2], const Unit& u, int wr, int wc, int fr, int fq) const {
        const int row0 = u.pm * BM + wr * 64 + fr, col0 = u.pn * BM + wc * 32 + 4 * fq;
#pragma unroll
        for (int ai = 0; ai < 2; ++ai)
#pragma unroll
            for (int m = 0; m < 4; ++m) { const size_t off = (size_t)(row0 + ai * HALF + m * 16) * ldc + col0;
#pragma unroll
                for (int bj = 0; bj < 2; ++bj)
#pragma unroll
                    for (int n = 0; n < 2; ++n) { const size_t o2 = off + bj * HALF + n * 16; const f32x4 a = acc[ai][bj][m][n], x = *(const f32x4*)(xo + o2), p = *(const f32x4*)(pp + o2);
                        f32x4 r; r[0] = x[0] + sigmoid_f(a[0]) * p[0]; r[1] = x[1] + sigmoid_f(a[1]) * p[1]; r[2] = x[2] + sigmoid_f(a[2]) * p[2]; r[3] = x[3] + sigmoid_f(a[3]) * p[3];
                        *(f32x4*)(xo + o2) = r; } }
    }
};
struct EpiLru {
    static constexpr bool PERM = true, AFTER_DRAIN = false;
    const bf16_t* xc; bf16_t* la; bf16_t* uo; const float* br; const float* bi; const float* sp;
    __device__ __forceinline__ void operator()(const f32x4 (&acc)[2][2][4][2], const Unit& u, int wr, int wc, int fr, int fq) const {
        const int row0 = u.pm * BM + wr * 64 + fr, ch0 = u.pn * HALF + wc * 32 + 8 * fq;
#pragma unroll
        for (int ai = 0; ai < 2; ++ai)
#pragma unroll
            for (int m = 0; m < 4; ++m) { const int row = row0 + ai * HALF + m * 16; const size_t off = (size_t)row * 1536 + ch0;
                const size_t ob = ((size_t)((row >> 13) * 96 + (ch0 >> 4)) * 8192 + (row & 8191)) * 16 + (ch0 & 15);
                const u32x4 xv = *(const u32x4*)(xc + off); unsigned lw[4], uw[4];
#pragma unroll
                for (int n = 0; n < 2; ++n) { const f32x4 brv = *(const f32x4*)(br + ch0 + 4 * n), biv = *(const f32x4*)(bi + ch0 + 4 * n), spv = *(const f32x4*)(sp + ch0 + 4 * n); float lv[4], uv[4];
#pragma unroll
                    for (int j = 0; j < 4; ++j) { const unsigned xw = xv[2 * n + (j >> 1)]; const float x = __uint_as_float((j & 1) ? (xw & 0xffff0000u) : (xw << 16));
                        const float r = sigmoid_f(acc[ai][0][m][n][j] + brv[j]), ig = sigmoid_f(acc[ai][1][m][n][j] + biv[j]);
                        const float l = spv[j] * r; lv[j] = l; uv[j] = sqrtf(fmaxf(1.0f - __expf(2.0f * l), 0.f)) * (ig * x); }
                    lw[2 * n] = cvt_pk_bf16(lv[0], lv[1]); lw[2 * n + 1] = cvt_pk_bf16(lv[2], lv[3]); uw[2 * n] = cvt_pk_bf16(uv[0], uv[1]); uw[2 * n + 1] = cvt_pk_bf16(uv[2], uv[3]); }
                *(u32x4*)(la + ob) = (u32x4){lw[0], lw[1], lw[2], lw[3]}; *(u32x4*)(uo + ob) = (u32x4){uw[0], uw[1], uw[2], uw[3]};
                asm volatile("" ::: "memory"); }
    }
};

template <class Epi, class Sched, bool ALIGN_EPI = false, bool SP2 = false>
__device__ __forceinline__ void gemm_phase(PG8_LAS unsigned char* lds, const Gemm g, const Sched& S, const Epi& E) {
    const int tid = threadIdx.x, wid = __builtin_amdgcn_readfirstlane(tid >> 6), lane = tid & 63, wr = wid >> 2, wc = wid & 3, fr = lane & 15, fq = lane >> 4;
    const int K = g.K, nt = K / BK;
    unsigned voffA[2], voffB[2];
#pragma unroll
    for (int i = 0; i < 2; ++i) { int R, C; stage_rc(tid * 16 + i * 8192, R, C); const int Rb = Epi::PERM ? ((R & ~31) + perm32(R & 31)) : R;
        voffA[i] = (unsigned)(R * g.lda + C) * 2u; voffB[i] = (unsigned)(Rb * K + C) * 2u; }
    const size_t kstep = (size_t)(BK * 2);
    const size_t hstepA = (size_t)HALF * g.lda * 2, hstepB = (size_t)HALF * K * 2;
    const size_t tstepA = 2 * hstepA, tstepB = 2 * hstepB;
    const unsigned ldsw = (unsigned)wid * 1024u;
    const int aoff = lds_byte(wr * 64 + fr, fq * 8), boff = lds_byte(wc * 32 + fr, fq * 8);
#define PG8_SA(b, h) (((b) * 2 + (h)) * HTB)
#define PG8_SB(b, h) ((4 + (b) * 2 + (h)) * HTB)
#define PG8_STAGE(bufoff, gbase, voff) do { _Pragma("unroll") for (int _i = 0; _i < 2; ++_i) \
        __builtin_amdgcn_global_load_lds((const unsigned*)((const char*)(gbase) + (voff)[_i]), (PG8_LAS unsigned*)(lds + (bufoff) + ldsw + _i * 8192), 16, 0, 0); } while (0)
#define PG8_LDA(dst, b, h) do { _Pragma("unroll") for (int m = 0; m < 4; ++m) _Pragma("unroll") for (int k = 0; k < 2; ++k) dst[m][k] = *(const PG8_LAS bf16x8*)(lds + PG8_SA(b, h) + aoff + m * 2048 + k * 1024); } while (0)
#define PG8_LDB(dst, b, h) do { _Pragma("unroll") for (int n = 0; n < 2; ++n) _Pragma("unroll") for (int k = 0; k < 2; ++k) dst[n][k] = *(const PG8_LAS bf16x8*)(lds + PG8_SB(b, h) + boff + n * 2048 + k * 1024); } while (0)
#define PG8_MMA(ai, bj, At, Bt) do { __builtin_amdgcn_s_setprio(1); _Pragma("unroll") for (int m = 0; m < 4; ++m) _Pragma("unroll") for (int n = 0; n < 2; ++n) _Pragma("unroll") for (int k = 0; k < 2; ++k) \
        acc[ai][bj][m][n] = __builtin_amdgcn_mfma_f32_16x16x32_bf16(Bt[n][k], At[m][k], acc[ai][bj][m][n], 0, 0, 0); __builtin_amdgcn_s_setprio(0); } while (0)
#define PG8_WAIT_V(n) asm volatile("s_waitcnt vmcnt(" #n ")" ::: "memory")
#define PG8_WAIT_L(n) asm volatile("s_waitcnt lgkmcnt(" #n ")" ::: "memory")
#define PG8_BAR __builtin_amdgcn_s_barrier()
#define PG8_SCHED __builtin_amdgcn_sched_barrier(0)
    Unit cur, nxt; int ui = 0;
    if (!S.next(0, cur)) return;
    f32x4 acc[2][2][4][2];
#pragma unroll
    for (int a = 0; a < 2; ++a)
#pragma unroll
        for (int b = 0; b < 2; ++b)
#pragma unroll
            for (int m = 0; m < 4; ++m)
#pragma unroll
                for (int n = 0; n < 2; ++n) acc[a][b][m][n] = (f32x4){0.f, 0.f, 0.f, 0.f};
    bf16x8 At[4][2], B0[2][2], B1[2][2];
    const char* cA = (const char*)g.A + (size_t)cur.pm * tstepA + (size_t)(cur.pn >> 1) * g.apn2 * 2; const char* cB = (const char*)g.Bt + (size_t)cur.pn * tstepB;
    S.a_ready(cur);
    if constexpr (SP2) {
        PG8_STAGE(PG8_SB(0, 0), cB, voffB); PG8_STAGE(PG8_SB(0, 1), cB + hstepB, voffB); PG8_STAGE(PG8_SA(0, 0), cA, voffA); PG8_STAGE(PG8_SA(0, 1), cA + hstepA, voffA);
        if (wr == 1) PG8_BAR;
        PG8_WAIT_V(2); PG8_BAR;
        PG8_STAGE(PG8_SB(1, 0), cB + kstep, voffB); PG8_STAGE(PG8_SA(1, 0), cA + kstep, voffA); PG8_STAGE(PG8_SB(1, 1), cB + hstepB + kstep, voffB);
        PG8_WAIT_V(6); PG8_BAR;
    } else {
        PG8_STAGE(PG8_SB(0, 0), cB, voffB); PG8_STAGE(PG8_SA(0, 0), cA, voffA); PG8_STAGE(PG8_SB(0, 1), cB + hstepB, voffB); PG8_STAGE(PG8_SA(0, 1), cA + hstepA, voffA);
        if (wr == 1) PG8_BAR;
        PG8_WAIT_V(4); PG8_BAR;
        PG8_STAGE(PG8_SB(1, 0), cB + kstep, voffB); PG8_STAGE(PG8_SA(1, 0), cA + kstep, voffA); PG8_STAGE(PG8_SB(1, 1), cB + hstepB + kstep, voffB);
        PG8_WAIT_V(6); PG8_BAR;
    }
    for (;;) {
        const bool has_next = S.next(ui + 1, nxt);
        const char* nA = has_next ? (const char*)g.A + (size_t)nxt.pm * tstepA + (size_t)(nxt.pn >> 1) * g.apn2 * 2 : cA; const char* nB = has_next ? (const char*)g.Bt + (size_t)nxt.pn * tstepB : cB;
        for (int t = 0; t < nt; t += 2) {
            const bool last = (t == nt - 2);
            const char* a1 = cA + (size_t)(t + 1) * kstep;
            const char* a2 = last ? nA : cA + (size_t)(t + 2) * kstep; const char* b2 = last ? nB : cB + (size_t)(t + 2) * kstep;
            const char* a3 = a2 + kstep; const char* b3 = b2 + kstep;
            if (last && has_next) S.a_ready(nxt);
            if constexpr (SP2) {
            PG8_LDB(B0, 0, 0); PG8_LDB(B1, 0, 1); PG8_SCHED; PG8_LDA(At, 0, 0); PG8_STAGE(PG8_SA(1, 1), a1 + hstepA, voffA);
            PG8_WAIT_V(8); PG8_WAIT_L(0); PG8_BAR; PG8_MMA(0, 0, At, B0); PG8_MMA(0, 1, At, B1); PG8_BAR; PG8_SCHED;
            PG8_LDA(At, 0, 1); PG8_STAGE(PG8_SB(0, 0), b2, voffB); PG8_STAGE(PG8_SB(0, 1), b2 + hstepB, voffB); PG8_STAGE(PG8_SA(0, 0), a2, voffA);
            PG8_WAIT_V(8); PG8_WAIT_L(0); PG8_BAR; PG8_MMA(1, 0, At, B0); PG8_MMA(1, 1, At, B1); PG8_BAR; PG8_SCHED;
            PG8_LDB(B0, 1, 0); PG8_LDB(B1, 1, 1); PG8_SCHED; PG8_LDA(At, 1, 0); PG8_STAGE(PG8_SA(0, 1), a2 + hstepA, voffA);
            PG8_WAIT_V(8); PG8_WAIT_L(0); PG8_BAR; PG8_MMA(0, 0, At, B0); PG8_MMA(0, 1, At, B1); PG8_BAR; PG8_SCHED;
            PG8_LDA(At, 1, 1); PG8_STAGE(PG8_SB(1, 0), b3, voffB); PG8_STAGE(PG8_SB(1, 1), b3 + hstepB, voffB); PG8_STAGE(PG8_SA(1, 0), a3, voffA);
            PG8_WAIT_V(8); PG8_WAIT_L(0); PG8_BAR; PG8_MMA(1, 0, At, B0); PG8_MMA(1, 1, At, B1); PG8_BAR; PG8_SCHED;
            } else {
            PG8_LDB(B0, 0, 0); PG8_SCHED; PG8_LDA(At, 0, 0); PG8_STAGE(PG8_SA(1, 1), a1 + hstepA, voffA);
            PG8_WAIT_L(8); PG8_BAR; PG8_WAIT_L(0); PG8_MMA(0, 0, At, B0); PG8_BAR; PG8_SCHED;
            PG8_LDB(B1, 0, 1); PG8_STAGE(PG8_SB(0, 0), b2, voffB);
            PG8_BAR; PG8_WAIT_L(0); PG8_MMA(0, 1, At, B1); PG8_BAR;
            PG8_LDA(At, 0, 1); PG8_STAGE(PG8_SA(0, 0), a2, voffA);
            PG8_BAR; PG8_WAIT_L(0); PG8_MMA(1, 0, At, B0); PG8_BAR; PG8_SCHED;
            PG8_STAGE(PG8_SB(0, 1), b2 + hstepB, voffB);
            PG8_WAIT_V(6); PG8_BAR; PG8_MMA(1, 1, At, B1); PG8_BAR;
            PG8_LDB(B0, 1, 0); PG8_SCHED; PG8_LDA(At, 1, 0); PG8_STAGE(PG8_SA(0, 1), a2 + hstepA, voffA);
            PG8_WAIT_L(8); PG8_BAR; PG8_WAIT_L(0); PG8_MMA(0, 0, At, B0); PG8_BAR; PG8_SCHED;
            PG8_LDB(B1, 1, 1); PG8_STAGE(PG8_SB(1, 0), b3, voffB);
            PG8_BAR; PG8_WAIT_L(0); PG8_MMA(0, 1, At, B1); PG8_BAR;
            PG8_LDA(At, 1, 1); PG8_STAGE(PG8_SA(1, 0), a3, voffA);
            PG8_BAR; PG8_WAIT_L(0); PG8_MMA(1, 0, At, B0); PG8_BAR; PG8_SCHED;
            PG8_STAGE(PG8_SB(1, 1), b3 + hstepB, voffB);
            PG8_WAIT_V(6); PG8_BAR; PG8_MMA(1, 1, At, B1); PG8_BAR;
            }
        }
        if constexpr (ALIGN_EPI) { if (wr == 0) PG8_BAR; }
        if constexpr (!Epi::AFTER_DRAIN) { E(acc, cur, wr, wc, fr, fq); S.done(cur); }
        if (!has_next) break;
#pragma unroll
        for (int a = 0; a < 2; ++a)
#pragma unroll
            for (int b = 0; b < 2; ++b)
#pragma unroll
                for (int m = 0; m < 4; ++m)
#pragma unroll
                    for (int n = 0; n < 2; ++n) acc[a][b][m][n] = (f32x4){0.f, 0.f, 0.f, 0.f};
        cur = nxt; cA = nA; cB = nB; ++ui;
        if constexpr (ALIGN_EPI) { if (wr == 1) PG8_BAR; }
    }
    PG8_WAIT_V(0);
    if constexpr (!ALIGN_EPI) { if (wr == 0) PG8_BAR; }
    PG8_BAR;
    if constexpr (Epi::AFTER_DRAIN) { E.fused(acc, cur, wr, wc, fr, fq, lds, wid, lane); S.done(cur); }
#undef PG8_SA
#undef PG8_SB
#undef PG8_STAGE
#undef PG8_LDA
#undef PG8_LDB
#undef PG8_MMA
#undef PG8_WAIT_V
#undef PG8_WAIT_L
#undef PG8_BAR
#undef PG8_SCHED
}
}

constexpr int NWAVES = 8, NTHREADS = NWAVES * 64;
constexpr int SEQ = 8192, NB = 2, M = NB * SEQ, D = 2048, FF = 5632, NIN = 5632, LW = 1536;
constexpr int OFF_K = 1536, OFF_V = 2048, OFF_XB = 2560, OFF_YB = 4096;
constexpr float LN_EPS = 1e-5f, ALPHA = 1.189207115002721f;
constexpr size_t MiB = 1u << 20;
constexpr size_t WS_LSE = 1 * MiB, WS_SP = 2 * MiB;
constexpr size_t WS_WFGU = 4 * MiB, WS_WFD = 48 * MiB;
constexpr size_t WS_WIN = 70 * MiB, WS_WOUT = 92 * MiB, WS_WPG = 100 * MiB, WS_WPP = 108 * MiB, WS_WRG = 109 * MiB, WS_PB = 111 * MiB;
constexpr size_t WS_XB = 120 * MiB;
constexpr size_t WS_H = 184 * MiB;
constexpr size_t WS_XC = 360 * MiB, WS_LA = 408 * MiB, WS_U = 456 * MiB, WS_END = 504 * MiB;
constexpr int LDS_BYTES = 147456;

#define LAS __attribute__((address_space(3)))
typedef unsigned short bf16;
typedef unsigned v4u __attribute__((ext_vector_type(4)));
typedef unsigned v2u __attribute__((ext_vector_type(2)));
typedef float f32x4 __attribute__((ext_vector_type(4)));
#define LDS_WAIT() asm volatile("s_waitcnt lgkmcnt(0)" ::: "memory")
__device__ __forceinline__ unsigned f2bf(float f) { unsigned u = __builtin_bit_cast(unsigned, f); return (u + 0x7fffu + ((u >> 16) & 1u)) >> 16; }
__device__ __forceinline__ unsigned pk2(float lo, float hi) { return f2bf(lo) | (f2bf(hi) << 16); }
__device__ __forceinline__ float bflo(unsigned w) { return __uint_as_float(w << 16); }
__device__ __forceinline__ float bfhi(unsigned w) { return __uint_as_float(w & 0xffff0000u); }
__device__ __forceinline__ float bf1(bf16 h) { return __uint_as_float((unsigned)h << 16); }
__device__ __forceinline__ float wave_sum(float v) {
#pragma unroll
    for (int o = 1; o < 64; o <<= 1) v += __shfl_xor(v, o);
    return v;
}
__device__ __forceinline__ float wave_max(float v) {
#pragma unroll
    for (int o = 1; o < 64; o <<= 1) v = fmaxf(v, __shfl_xor(v, o));
    return v;
}
__device__ __forceinline__ float gelu_tanh(float x) {
    const float y = 0.7978845608028654f * (x + 0.044715f * x * x * x);
    const float t = 1.0f - 2.0f * __builtin_amdgcn_rcpf(1.0f + __expf(2.0f * y));
    return 0.5f * x * (1.0f + t);
}

struct Args { const float* in[26]; float* out; unsigned char* ws; int ph_lo, ph_hi; };

__device__ __forceinline__ void tr_item(const float* W, int N, int k0, int n0, bf16* WT, int drow0, int ldt, int dcol0, LAS float* scr, int lane) {
#pragma unroll 8
    for (int i = 0; i < 32; ++i) { const int kk = 2 * i + (lane >> 5); scr[kk * 33 + (lane & 31)] = W[(size_t)(k0 + kk) * N + n0 + (lane & 31)]; }
    LDS_WAIT(); asm volatile("" ::: "memory");
    const int c = lane & 7;
#pragma unroll
    for (int j = 0; j < 4; ++j) { const int n = (lane >> 3) + 8 * j; const LAS float* s = scr + (8 * c) * 33 + n;
        v4u o; o.x = pk2(s[0 * 33], s[1 * 33]); o.y = pk2(s[2 * 33], s[3 * 33]); o.z = pk2(s[4 * 33], s[5 * 33]); o.w = pk2(s[6 * 33], s[7 * 33]);
        *(v4u*)(WT + (size_t)(drow0 + n) * ldt + dcol0 + 8 * c) = o; }
    LDS_WAIT(); asm volatile("" ::: "memory");
}
__device__ __forceinline__ void tr_matrix_item(const float* W, int K, int N, bf16* WT, int mode, int item, LAS float* scr, int lane) {
    const int nblk = N / 32, kb = item / nblk, nb = item % nblk, k0 = 64 * kb, n0 = 32 * nb;
    int drow0 = n0; if (mode) drow0 = 256 * (n0 >> 7) + (n0 & 127) + (mode == 2 ? 128 : 0);
    tr_item(W, N, k0, n0, WT, drow0, K, k0, scr, lane);
}
constexpr int IT_FF = (D / 64) * (FF / 32);
__device__ __forceinline__ void convert_ffn(const float* wg, const float* wu, const float* wd, unsigned char* ws, LAS float* scr, int gw, int NGW, int lane) {
    for (int it = gw; it < 3 * IT_FF; it += NGW) {
        int r = it;
        if (r < IT_FF) { tr_matrix_item(wg, D, FF, (bf16*)(ws + WS_WFGU), 1, r, scr, lane); continue; } r -= IT_FF;
        if (r < IT_FF) { tr_matrix_item(wu, D, FF, (bf16*)(ws + WS_WFGU), 2, r, scr, lane); continue; } r -= IT_FF;
        tr_matrix_item(wd, FF, D, (bf16*)(ws + WS_WFD), 0, r, scr, lane);
    }
}
__device__ __forceinline__ void convert_rest(const Args& a, LAS float* scr, int gw, int NGW, int lane) {
    unsigned char* ws = a.ws;
    constexpr int I_IN = IT_FF, I_SQ = (D / 64) * (D / 32), I_PP = (256 / 64) * (D / 32), I_RG = 24 * 8;
    for (int it = gw; it < I_IN + 2 * I_SQ + I_PP + I_RG; it += NGW) {
        int r = it;
        if (r < I_IN) { tr_matrix_item(a.in[8], D, NIN, (bf16*)(ws + WS_WIN), 0, r, scr, lane); continue; } r -= I_IN;
        if (r < I_SQ) { tr_matrix_item(a.in[16], D, D, (bf16*)(ws + WS_WOUT), 0, r, scr, lane); continue; } r -= I_SQ;
        if (r < I_SQ) { tr_matrix_item(a.in[25], D, D, (bf16*)(ws + WS_WPG), 0, r, scr, lane); continue; } r -= I_SQ;
        if (r < I_PP) { tr_matrix_item(a.in[24], 256, D, (bf16*)(ws + WS_WPP), 0, r, scr, lane); continue; } r -= I_PP;
        { const int mi = r >> 3, sub = r & 7, gate = mi / 12, g = mi % 12, kb = sub >> 2, nb = sub & 3;
          const float* W = (gate ? a.in[13] : a.in[11]) + (size_t)g * 128 * 128; bf16* WT = (bf16*)(ws + WS_WRG);
          const int drow0 = 256 * g + 128 * gate + 32 * nb;
          tr_item(W, 128, 64 * kb, 32 * nb, WT, drow0, 256, 128 * (g & 1) + 64 * kb, scr, lane);
          const int c = lane & 7;
#pragma unroll
          for (int j = 0; j < 4; ++j) { const int n = (lane >> 3) + 8 * j; *(v4u*)(WT + (size_t)(drow0 + n) * 256 + 128 * ((g & 1) ^ 1) + 64 * kb + 8 * c) = (v4u){0u, 0u, 0u, 0u}; } }
    }
}
__device__ __forceinline__ void cvt_rows(const float* src, bf16* dst, size_t n, int gtid, int gthreads) {
    for (size_t i = (size_t)gtid * 8; i < n; i += (size_t)gthreads * 8) {
        const f32x4 a = *(const f32x4*)(src + i), b = *(const f32x4*)(src + i + 4);
        *(v4u*)(dst + i) = (v4u){pk2(a[0], a[1]), pk2(a[2], a[3]), pk2(b[0], b[1]), pk2(b[2], b[3])};
    }
}
__device__ __forceinline__ void ln_rows(float* z, bf16* xb, const float* g, const float* b, int gw, int NGW, int lane) {
    for (int m = gw; m < M; m += NGW) {
        f32x4* zr = (f32x4*)(z + (size_t)m * D) + lane; f32x4 v[8]; float s = 0.f;
#pragma unroll
        for (int j = 0; j < 8; ++j) { v[j] = zr[64 * j]; s += (v[j][0] + v[j][1]) + (v[j][2] + v[j][3]); }
        const float mean = wave_sum(s) * (1.f / D); float s2 = 0.f;
#pragma unroll
        for (int j = 0; j < 8; ++j) { v[j] = v[j] - mean; s2 += (v[j][0] * v[j][0] + v[j][1] * v[j][1]) + (v[j][2] * v[j][2] + v[j][3] * v[j][3]); }
        const float rstd = 1.f / sqrtf(wave_sum(s2) * (1.f / D) + LN_EPS);
        v2u* o8 = (v2u*)(xb + (size_t)m * D) + lane;
#pragma unroll
        for (int j = 0; j < 8; ++j) { const f32x4 gg = *((const f32x4*)g + lane + 64 * j), bb = *((const f32x4*)b + lane + 64 * j);
            const f32x4 y = v[j] * rstd * gg + bb; zr[64 * j] = y; o8[64 * j] = (v2u){pk2(y[0], y[1]), pk2(y[2], y[3])}; }
    }
}
__device__ __forceinline__ void rotary_rows(bf16* proj, const int* positions, int gtid, int gthreads) {
    constexpr float INVF[16] = {1.000000000e+00f, 4.403665960e-01f, 1.939227432e-01f, 8.539710194e-02f, 3.760603070e-02f, 1.656043902e-02f, 7.292664610e-03f, 3.211445874e-03f,
                                1.414213562e-03f, 6.227723788e-04f, 2.742481884e-04f, 1.207697351e-04f, 5.318296098e-05f, 2.341999971e-05f, 1.031338616e-05f, 4.541670478e-06f};
    for (int it = gtid; it < M * 16; it += gthreads) {
        const int m = it >> 4, hh = it & 15; v4u* p = (v4u*)(proj + (size_t)m * NIN + hh * 128);
        const v4u a0 = p[0], a1 = p[1], b0 = p[2], b1 = p[3]; const float pos = (float)positions[m];
        float t1[16], t2[16];
#pragma unroll
        for (int i = 0; i < 4; ++i) { t1[2 * i] = bflo(a0[i]); t1[2 * i + 1] = bfhi(a0[i]); t1[8 + 2 * i] = bflo(a1[i]); t1[8 + 2 * i + 1] = bfhi(a1[i]);
                                      t2[2 * i] = bflo(b0[i]); t2[2 * i + 1] = bfhi(b0[i]); t2[8 + 2 * i] = bflo(b1[i]); t2[8 + 2 * i + 1] = bfhi(b1[i]); }
        float o1[16], o2[16];
#pragma unroll
        for (int i = 0; i < 16; ++i) { const float ang = pos * INVF[i]; const float c = cosf(ang), s = sinf(ang); o1[i] = t1[i] * c - t2[i] * s; o2[i] = t2[i] * c + t1[i] * s; }
        p[0] = (v4u){pk2(o1[0], o1[1]), pk2(o1[2], o1[3]), pk2(o1[4], o1[5]), pk2(o1[6], o1[7])};
        p[1] = (v4u){pk2(o1[8], o1[9]), pk2(o1[10], o1[11]), pk2(o1[12], o1[13]), pk2(o1[14], o1[15])};
        p[2] = (v4u){pk2(o2[0], o2[1]), pk2(o2[2], o2[3]), pk2(o2[4], o2[5]), pk2(o2[6], o2[7])};
        p[3] = (v4u){pk2(o2[8], o2[9]), pk2(o2[10], o2[11]), pk2(o2[12], o2[13]), pk2(o2[14], o2[15])};
    }
}
__device__ __forceinline__ void conv_rows(const bf16* proj, const float* cw, const float* cb, bf16* xc, int gtid, int gthreads) {
    for (int it = gtid; it < M * (LW / 8); it += gthreads) {
        const int m = it / (LW / 8), c8 = (it % (LW / 8)) * 8, t = m & (SEQ - 1);
        float acc[8];
        { const f32x4 b0 = *(const f32x4*)(cb + c8), b1 = *(const f32x4*)(cb + c8 + 4); acc[0] = b0[0]; acc[1] = b0[1]; acc[2] = b0[2]; acc[3] = b0[3]; acc[4] = b1[0]; acc[5] = b1[1]; acc[6] = b1[2]; acc[7] = b1[3]; }
#pragma unroll
        for (int j = 0; j < 4; ++j) { if (t - 3 + j >= 0) {
            const v4u xv = *(const v4u*)(proj + (size_t)(m - 3 + j) * NIN + OFF_XB + c8);
            const f32x4 w0 = *(const f32x4*)(cw + j * LW + c8), w1 = *(const f32x4*)(cw + j * LW + c8 + 4);
            acc[0] += w0[0] * bflo(xv[0]); acc[1] += w0[1] * bfhi(xv[0]); acc[2] += w0[2] * bflo(xv[1]); acc[3] += w0[3] * bfhi(xv[1]);
            acc[4] += w1[0] * bflo(xv[2]); acc[5] += w1[1] * bfhi(xv[2]); acc[6] += w1[2] * bflo(xv[3]); acc[7] += w1[3] * bfhi(xv[3]); } }
        *(v4u*)(xc + (size_t)m * LW + c8) = (v4u){pk2(acc[0], acc[1]), pk2(acc[2], acc[3]), pk2(acc[4], acc[5]), pk2(acc[6], acc[7])};
    }
}
__device__ __forceinline__ void attn_scalar(bf16* proj, float* lse, int gw, int NGW, int lane) {
    const int total = M * 12, per = (total + NGW - 1) / NGW, Tend = min(total, (gw + 1) * per);
    for (int T = gw * per; T < Tend; ++T) {
        const int hq = T / M, m = T % M, t = m & (SEQ - 1), g = hq >> 2, h = hq & 3, dsh = 2 * g;
        bf16* qp = proj + (size_t)m * NIN + hq * 128;
        const bf16* kb = proj + OFF_K + h * 128; const bf16* vb = proj + OFF_V + h * 128;
        const int jmax = min(128, t >> dsh);
        v4u qv[16];
#pragma unroll
        for (int c = 0; c < 16; ++c) qv[c] = *(const v4u*)(qp + 8 * c);
        float sc[3];
#pragma unroll
        for (int ps = 0; ps < 3; ++ps) {
            const int j = lane + 64 * ps; float s = -INFINITY;
            if (j <= jmax && (ps < 2 || lane == 0)) {
                const bf16* kr = kb + (size_t)(m - (j << dsh)) * NIN; float d0 = 0.f, d1 = 0.f;
#pragma unroll
                for (int c = 0; c < 16; ++c) { const v4u kv = *(const v4u*)(kr + 8 * c);
#pragma unroll
                    for (int e = 0; e < 4; ++e) { d0 += bflo(qv[c][e]) * bflo(kv[e]); d1 += bfhi(qv[c][e]) * bfhi(kv[e]); } }
                s = (d0 + d1) * 0.08838834764831845f;
            }
            sc[ps] = s;
        }
        const float mx = wave_max(fmaxf(fmaxf(sc[0], sc[1]), sc[2]));
        const float e0 = __expf(sc[0] - mx), e1 = __expf(sc[1] - mx), e2 = __expf(sc[2] - mx);
        const float den = wave_sum(e0 + e1 + e2);
        float a0 = 0.f, a1 = 0.f;
        for (int j = 0; j <= jmax; ++j) {
            const float src = (j < 64) ? e0 : ((j < 128) ? e1 : e2);
            const float p = __uint_as_float(__builtin_amdgcn_readlane(__float_as_uint(src), j & 63));
            const unsigned vv = *(const unsigned*)(vb + (size_t)(m - (j << dsh)) * NIN + 2 * lane);
            a0 += p * bflo(vv); a1 += p * bfhi(vv);
        }
        const float inv = 1.0f / den;
        *(unsigned*)(qp + 2 * lane) = pk2(a0 * inv, a1 * inv);
        if (lane == 0) lse[(size_t)m * 12 + hq] = mx + __logf(den);
    }
}

typedef short s16x8 __attribute__((ext_vector_type(8)));
typedef short s16x4 __attribute__((ext_vector_type(4)));
typedef float f32x16 __attribute__((ext_vector_type(16)));
typedef float f32x2_t __attribute__((ext_vector_type(2))); typedef __bf16 bf16x2_t __attribute__((ext_vector_type(2)));
__device__ __forceinline__ unsigned cvtpk(float lo, float hi) { f32x2_t v = {lo, hi}; bf16x2_t b = __builtin_convertvector(v, bf16x2_t); return __builtin_bit_cast(unsigned, b); }
__device__ __forceinline__ s16x4 vtr(LAS unsigned char* p) { return __builtin_bit_cast(s16x4, __builtin_amdgcn_ds_read_tr16_b64_v4i16((LAS s16x4*)p)); }
__device__ __forceinline__ int crow(int r, int h) { return (r & 3) + 8 * (r >> 2) + 4 * h; }
__device__ __forceinline__ void attn_mfma(bf16* proj, float* lse, LAS unsigned char* lds, int gw, int NGW, int wave, int lane) {
    LAS unsigned char* vbuf = lds + wave * 8192;
    const int q32 = lane & 31, hh = lane >> 5;
    const int trl = (4 * hh + ((lane & 15) >> 2)) * 64 + ((lane >> 4) & 1) * 32 + (lane & 3) * 8;
    const float C = 0.08838834764831845f * 1.4426950408889634f;
    for (int T = gw; T < 6144; T += NGW) {
        const int qg = T & 3; int xx = T >> 2; const int rn = xx & 63; xx >>= 6; const int hq = xx % 12, b = xx / 12;
        const int g = hq >> 2, hkv = hq & 3, dsh = 2 * g, nbsh = 6 - dsh;
        const int r = rn >> nbsh, n = rn & ((1 << nbsh) - 1);
        const size_t mq = (size_t)b * SEQ + (size_t)(((128 * n + 32 * qg + q32) << dsh) + r);
        bf16* qp = proj + mq * NIN + hq * 128;
        s16x8 qf[8];
#pragma unroll
        for (int ks = 0; ks < 8; ++ks) qf[ks] = *(const s16x8*)(qp + 16 * ks + 8 * hh);
        f32x16 O[4];
#pragma unroll
        for (int dt = 0; dt < 4; ++dt)
#pragma unroll
            for (int e = 0; e < 16; ++e) O[dt][e] = 0.f;
        float mrun = -INFINITY, lrun = 0.f;
        const int iq = 32 * qg + q32;
        const int kt1 = qg + 4, kt0 = (n == 0 && qg < 4) ? 4 : qg;
        for (int kt = kt0; kt <= kt1; ++kt) {
            const int km0 = 128 * (n - 1) + 32 * kt;
            const bf16* kp = proj + ((size_t)b * SEQ + (size_t)(((km0 + q32) << dsh) + r)) * NIN + OFF_K + hkv * 128 + 8 * hh;
            s16x8 kf[8];
#pragma unroll
            for (int ks = 0; ks < 8; ++ks) kf[ks] = *(const s16x8*)(kp + 16 * ks);
#pragma unroll
            for (int i = 0; i < 8; ++i) { const int c = lane + 64 * i, key = c >> 4, dc = c & 15;
                const v4u v = *(const v4u*)(proj + ((size_t)b * SEQ + (size_t)(((km0 + key) << dsh) + r)) * NIN + OFF_V + hkv * 128 + 8 * dc);
                *(LAS v4u*)(vbuf + ((dc >> 2) * 4 + (key >> 3)) * 512 + (key & 7) * 64 + (dc & 3) * 16) = v; }
            f32x16 S;
#pragma unroll
            for (int e = 0; e < 16; ++e) S[e] = 0.f;
#pragma unroll
            for (int ks = 0; ks < 8; ++ks) S = __builtin_amdgcn_mfma_f32_32x32x16_bf16(kf[ks], qf[ks], S, 0, 0, 0);
            float t[16]; float mt = -INFINITY;
#pragma unroll
            for (int e = 0; e < 16; ++e) { const int j = 32 * kt + crow(e, hh); float tv = S[e] * C;
                if (kt == qg && j < iq) tv = -INFINITY;
                if (kt == kt1 && j > iq + 128) tv = -INFINITY;
                t[e] = tv; mt = fmaxf(mt, tv); }
            mt = fmaxf(mt, __shfl_xor(mt, 32));
            const float mnew = fmaxf(mrun, mt), alpha = __builtin_amdgcn_exp2f(mrun - mnew);
            float ps = 0.f;
#pragma unroll
            for (int e = 0; e < 16; ++e) { t[e] = __builtin_amdgcn_exp2f(t[e] - mnew); ps += t[e]; }
            lrun = lrun * alpha + ps; mrun = mnew;
#pragma unroll
            for (int dt = 0; dt < 4; ++dt) O[dt] = O[dt] * alpha;
            s16x8 pb[2];
#pragma unroll
            for (int s = 0; s < 2; ++s) { v4u w; w[0] = cvtpk(t[8 * s], t[8 * s + 1]); w[1] = cvtpk(t[8 * s + 2], t[8 * s + 3]); w[2] = cvtpk(t[8 * s + 4], t[8 * s + 5]); w[3] = cvtpk(t[8 * s + 6], t[8 * s + 7]); pb[s] = __builtin_bit_cast(s16x8, w); }
            asm volatile("" ::: "memory");
#pragma unroll
            for (int dt = 0; dt < 4; ++dt)
#pragma unroll
                for (int s = 0; s < 2; ++s) { const s16x4 lo = vtr(vbuf + (dt * 4 + 2 * s) * 512 + trl), hi = vtr(vbuf + (dt * 4 + 2 * s + 1) * 512 + trl);
                    const s16x8 vf = {lo[0], lo[1], lo[2], lo[3], hi[0], hi[1], hi[2], hi[3]};
                    O[dt] = __builtin_amdgcn_mfma_f32_32x32x16_bf16(vf, pb[s], O[dt], 0, 0, 0); }
            asm volatile("" ::: "memory");
        }
        const float ltot = lrun + __shfl_xor(lrun, 32), inv = 1.0f / ltot;
#pragma unroll
        for (int dt = 0; dt < 4; ++dt)
#pragma unroll
            for (int rg = 0; rg < 4; ++rg) { const int d0 = 32 * dt + 8 * rg + 4 * hh;
                *(v2u*)(qp + d0) = (v2u){cvtpk(O[dt][4 * rg] * inv, O[dt][4 * rg + 1] * inv), cvtpk(O[dt][4 * rg + 2] * inv, O[dt][4 * rg + 3] * inv)}; }
        if (hh == 0) lse[mq * 12 + hq] = (mrun + __builtin_amdgcn_logf(ltot)) * 0.6931471805599453f;
    }
}
__device__ __forceinline__ void merge_rows(const bf16* proj, const float* lse, bf16* cat, int gtid, int gthreads) {
    for (int it = gtid; it < M * 64; it += gthreads) {
        const int m = it >> 6, h = (it >> 4) & 3, c8 = (it & 15) * 8;
        const float l0 = lse[(size_t)m * 12 + h], l1 = lse[(size_t)m * 12 + 4 + h], l2 = lse[(size_t)m * 12 + 8 + h];
        const float mx = fmaxf(fmaxf(l0, l1), l2); float w0 = __expf(l0 - mx), w1 = __expf(l1 - mx), w2 = __expf(l2 - mx);
        const float inv = 1.0f / (w0 + w1 + w2); w0 *= inv; w1 *= inv; w2 *= inv;
        const bf16* qp = proj + (size_t)m * NIN + h * 128 + c8;
        const v4u o0 = *(const v4u*)qp, o1 = *(const v4u*)(qp + 512), o2 = *(const v4u*)(qp + 1024);
        v4u r;
#pragma unroll
        for (int e = 0; e < 4; ++e) r[e] = pk2(w0 * bflo(o0[e]) + w1 * bflo(o1[e]) + w2 * bflo(o2[e]), w0 * bfhi(o0[e]) + w1 * bfhi(o1[e]) + w2 * bfhi(o2[e]));
        *(v4u*)(cat + (size_t)m * D + h * 128 + c8) = r;
    }
}
__device__ __forceinline__ void scan_items(const bf16* la, const bf16* uu, const bf16* proj, bf16* cat, LAS float* sm, int G, int bid, int tid) {
    const int half = tid & 1, sl = tid >> 1, ce = half * 8;
    LAS float* sA = sm; LAS float* sH = sm + 4096; LAS float* gA = sm + 8192; LAS float* gH = sm + 8192 + 512;
    for (int item = bid; item < NB * (LW / 16); item += G) {
        const int b = item / (LW / 16), cb = item % (LW / 16);
        const bf16* lp = la + ((size_t)item * SEQ + sl * 32) * 16 + ce; const bf16* up = uu + ((size_t)item * SEQ + sl * 32) * 16 + ce;
        float A[8], H[8];
#pragma unroll
        for (int e = 0; e < 8; ++e) { A[e] = 0.f; H[e] = 0.f; }
#pragma unroll 4
        for (int t = 0; t < 32; ++t) { const v4u lv = *(const v4u*)(lp + t * 16), uv = *(const v4u*)(up + t * 16);
#pragma unroll
            for (int e = 0; e < 4; ++e) { const float l0 = bflo(lv[e]), l1 = bfhi(lv[e]); H[2 * e] = __expf(l0) * H[2 * e] + bflo(uv[e]); H[2 * e + 1] = __expf(l1) * H[2 * e + 1] + bfhi(uv[e]); A[2 * e] += l0; A[2 * e + 1] += l1; } }
#pragma unroll
        for (int e = 0; e < 8; ++e) { sA[sl * 16 + ce + e] = A[e]; sH[sl * 16 + ce + e] = H[e]; }
        __syncthreads();
        { const int ch = tid & 15, grp = tid >> 4; float a = 0.f, h = 0.f;
#pragma unroll
          for (int k = 0; k < 8; ++k) { const float aa = sA[(grp * 8 + k) * 16 + ch]; h = __expf(aa) * h + sH[(grp * 8 + k) * 16 + ch]; a += aa; }
          gA[grp * 16 + ch] = a; gH[grp * 16 + ch] = h; }
        __syncthreads();
        float h[8];
#pragma unroll
        for (int e = 0; e < 8; ++e) h[e] = 0.f;
        const int grp = sl >> 3;
        for (int gg = 0; gg < grp; ++gg)
#pragma unroll
            for (int e = 0; e < 8; ++e) h[e] = __expf(gA[gg * 16 + ce + e]) * h[e] + gH[gg * 16 + ce + e];
        for (int s2 = grp * 8; s2 < sl; ++s2)
#pragma unroll
            for (int e = 0; e < 8; ++e) h[e] = __expf(sA[s2 * 16 + ce + e]) * h[e] + sH[s2 * 16 + ce + e];
        const size_t m0 = (size_t)b * SEQ + sl * 32;
#pragma unroll 4
        for (int t = 0; t < 32; ++t) { const v4u lv = *(const v4u*)(lp + t * 16), uv = *(const v4u*)(up + t * 16), yv = *(const v4u*)(proj + (m0 + t) * NIN + OFF_YB + cb * 16 + ce);
            v4u o;
#pragma unroll
            for (int e = 0; e < 4; ++e) { h[2 * e] = __expf(bflo(lv[e])) * h[2 * e] + bflo(uv[e]); h[2 * e + 1] = __expf(bfhi(lv[e])) * h[2 * e + 1] + bfhi(uv[e]);
                o[e] = pk2(h[2 * e] * gelu_tanh(bflo(yv[e])), h[2 * e + 1] * gelu_tanh(bfhi(yv[e]))); }
            *(v4u*)(cat + (m0 + t) * D + 512 + cb * 16 + ce) = o; }
        __syncthreads();
    }
}

#ifndef MK_N_LAUNCHES
#define MK_N_LAUNCHES 1
#endif
constexpr int NPHASES = 14;
__global__ void __launch_bounds__(NTHREADS, 2) fwd_kernel(Args a) {
    extern __shared__ __attribute__((aligned(16))) unsigned char lds_raw[];
    LAS unsigned char* lds = (LAS unsigned char*)lds_raw;
    const int tid = threadIdx.x, lane = tid & 63, wave = __builtin_amdgcn_readfirstlane(tid >> 6);
    const int G = gridDim.x, bid = blockIdx.x, gw = bid * NWAVES + wave, NGW = G * NWAVES, gtid = bid * NTHREADS + tid, gthreads = G * NTHREADS;
    LAS float* scr = (LAS float*)(lds + wave * 16384);
    unsigned char* ws = a.ws;
    bf16* XB = (bf16*)(ws + WS_XB); bf16* HB = (bf16*)(ws + WS_H); float* PP = (float*)(ws + WS_H);
    bf16* XC = (bf16*)(ws + WS_XC); bf16* LA = (bf16*)(ws + WS_LA); bf16* UU = (bf16*)(ws + WS_U); float* LSE = (float*)(ws + WS_LSE);
    const float* x = a.in[0]; float* out = a.out;
    const int lo = a.ph_lo, hi = a.ph_hi;
#ifndef PHASE_MASK
#define PHASE_MASK 0xffff
#endif
#define IN(k) (((PHASE_MASK >> (k)) & 1) && lo <= (k) && (k) < hi)
#define SEAM(k) do { if (IN((k) + 1)) cg::this_grid().sync(); } while (0)
    typedef pg8::StaticOrder SO;
    if (IN(0)) {
        convert_ffn(a.in[3], a.in[4], a.in[5], ws, scr, gw, NGW, lane);
        convert_rest(a, scr, gw, NGW, lane);
        cvt_rows(x, XB, (size_t)M * D, gtid, gthreads);
        cvt_rows(a.in[1], (bf16*)(ws + WS_PB), (size_t)M * 256, gtid, gthreads);
        if (gtid < LW) ((float*)(ws + WS_SP))[gtid] = -8.0f * log1pf(expf(-a.in[15][gtid]));
        __syncthreads(); SEAM(0);
    }
    if (IN(1)) {
        pg8::Gemm g{XB, (const bf16*)(ws + WS_WFGU), M, 2 * FF, D, D, 0}; SO S; S.init(M, 2 * FF, G, bid);
        pg8::EpiSwiglu E{HB, FF};
        pg8::gemm_phase<pg8::EpiSwiglu, SO, true, true>(lds, g, S, E);
        SEAM(1);
    }
    if (IN(2)) {
        pg8::Gemm g{HB, (const bf16*)(ws + WS_WFD), M, D, FF, FF, 0}; SO S; S.init(M, D, G, bid);
        pg8::EpiResF32 E{x, out, D, ALPHA, 0.5f};
        pg8::gemm_phase<pg8::EpiResF32, SO, true, true>(lds, g, S, E);
        SEAM(2);
    }
    if (IN(3)) {
        ln_rows(out, XB, a.in[6], a.in[7], gw, NGW, lane);
        convert_ffn(a.in[19], a.in[20], a.in[21], ws, scr, gw, NGW, lane);
        __syncthreads(); SEAM(3);
    }
    if (IN(4)) {
        pg8::Gemm g{XB, (const bf16*)(ws + WS_WIN), M, NIN, D, D, 0}; SO S; S.init(M, NIN, G, bid);
        pg8::EpiBf16 E{HB, NIN};
        pg8::gemm_phase<pg8::EpiBf16, SO, true, true>(lds, g, S, E);
        SEAM(4);
    }
    if (IN(5)) {
        rotary_rows(HB, (const int*)a.in[2], gtid, gthreads);
        conv_rows(HB, a.in[9], a.in[10], XC, gtid, gthreads);
        SEAM(5);
    }
    if (IN(6)) {
        pg8::Gemm g{XC, (const bf16*)(ws + WS_WRG), M, 3072, 256, LW, 256}; SO S; S.init(M, 3072, G, bid);
        pg8::EpiLru E{XC, LA, UU, a.in[12], a.in[14], (const float*)(ws + WS_SP)};
        pg8::gemm_phase<pg8::EpiLru, SO, true, true>(lds, g, S, E);
        __syncthreads();
        attn_mfma(HB, LSE, lds, gw, NGW, wave, lane);
        SEAM(6);
    }
    if (IN(7)) {
        __syncthreads();
        scan_items(LA, UU, HB, XB, (LAS float*)lds, G, bid, tid);
        merge_rows(HB, LSE, XB, gtid, gthreads);
        SEAM(7);
    }
    if (IN(8)) {
        pg8::Gemm g{XB, (const bf16*)(ws + WS_WOUT), M, D, D, D, 0}; SO S; S.init(M, D, G, bid);
        pg8::EpiResF32 E{out, out, D, ALPHA, 1.0f};
        pg8::gemm_phase<pg8::EpiResF32, SO, true, true>(lds, g, S, E);
        SEAM(8);
    }
    if (IN(9)) { ln_rows(out, XB, a.in[17], a.in[18], gw, NGW, lane); SEAM(9); }
    if (IN(10)) {
        pg8::Gemm g{XB, (const bf16*)(ws + WS_WFGU), M, 2 * FF, D, D, 0}; SO S; S.init(M, 2 * FF, G, bid);
        pg8::EpiSwiglu E{HB, FF};
        pg8::gemm_phase<pg8::EpiSwiglu, SO, true, true>(lds, g, S, E);
        SEAM(10);
    }
    if (IN(11)) {
        pg8::Gemm g{HB, (const bf16*)(ws + WS_WFD), M, D, FF, FF, 0}; SO S; S.init(M, D, G, bid);
        pg8::EpiResF32 E{out, out, D, ALPHA, 0.5f};
        pg8::gemm_phase<pg8::EpiResF32, SO, true, true>(lds, g, S, E);
        SEAM(11);
    }
    if (IN(12)) {
        ln_rows(out, XB, a.in[22], a.in[23], gw, NGW, lane);
        __syncthreads();
        pg8::Gemm g{(const bf16*)(ws + WS_PB), (const bf16*)(ws + WS_WPP), M, D, 256, 256, 0}; SO S; S.init(M, D, G, bid);
        pg8::EpiResF32 E{nullptr, PP, D, 0.f, 1.0f};
        pg8::gemm_phase<pg8::EpiResF32, SO, true, true>(lds, g, S, E);
        SEAM(12);
    }
    if (IN(13)) {
        pg8::Gemm g{XB, (const bf16*)(ws + WS_WPG), M, D, D, D, 0}; SO S; S.init(M, D, G, bid);
        pg8::EpiPle E{out, PP, D};
        pg8::gemm_phase<pg8::EpiPle, SO, true, true>(lds, g, S, E);
    }
#undef IN
#undef SEAM
}

extern "C" void kernel_launch(void* const* d_in, const int* in_sizes, int n_in, void* d_out, int out_size, void* d_ws, size_t ws_size, hipStream_t stream) {
    static int grid = 0;
    if (grid == 0) {
        if (n_in != 26 || out_size != M * D || ws_size < WS_END) { fprintf(stderr, "kernel_launch: unexpected problem (n_in %d, out %d, ws %zu)\n", n_in, out_size, ws_size); grid = -1; return; }
        int dev = 0, cus = 0, per_cu = 0;
        (void)hipGetDevice(&dev); (void)hipDeviceGetAttribute(&cus, hipDeviceAttributeMultiprocessorCount, dev);
        if (hipFuncSetAttribute((const void*)fwd_kernel, hipFuncAttributeMaxDynamicSharedMemorySize, LDS_BYTES) != hipSuccess) { fprintf(stderr, "kernel_launch: hipFuncSetAttribute failed\n"); grid = -1; return; }
        if (hipOccupancyMaxActiveBlocksPerMultiprocessor(&per_cu, (const void*)fwd_kernel, NTHREADS, LDS_BYTES) != hipSuccess || per_cu < 1) { fprintf(stderr, "kernel_launch: occupancy query says %d\n", per_cu); per_cu = 1; }
        (void)hipGetLastError();
        grid = cus * 1;
    }
    if (grid < 0) return;
    Args a{};
    for (int i = 0; i < 26; ++i) a.in[i] = (const float*)d_in[i];
    a.out = (float*)d_out; a.ws = (unsigned char*)d_ws;
#if MK_N_LAUNCHES == 1
    a.ph_lo = 0; a.ph_hi = NPHASES;
    void* args[] = {&a};
    hipError_t e = hipLaunchCooperativeKernel((const void*)fwd_kernel, dim3(grid), dim3(NTHREADS), args, LDS_BYTES, stream);
    if (e != hipSuccess) fprintf(stderr, "cooperative launch failed: %s (grid %d)\n", hipGetErrorString(e), grid);
#else
    for (int p = 0; p < NPHASES; ++p) { a.ph_lo = p; a.ph_hi = p + 1; hipLaunchKernelGGL(fwd_kernel, dim3(grid), dim3(NTHREADS), LDS_BYTES, stream, a); }
#endif
}
```

```cpp
#include <hip/hip_runtime.h>
#include <hip/hip_cooperative_groups.h>
#include <cstdio>
#include <cstdint>
#include <type_traits>
namespace cg = cooperative_groups;
namespace pg8 {
#define PG8_LAS __attribute__((address_space(3)))
typedef unsigned short bf16_t;
typedef short bf16x8 __attribute__((ext_vector_type(8)));
typedef float f32x4 __attribute__((ext_vector_type(4)));
typedef unsigned u32x4 __attribute__((ext_vector_type(4)));
constexpr int BM = 256, BK = 64, HALF = 128, HTB = HALF * BK * 2  , STAGE_BYTES = 8 * HTB, NXCD = 8, WGM = 8;

__host__ __device__ __forceinline__ int lds_byte(int r, int c) { const int st = (r >> 4) * 2 + (c >> 5), rr = r & 15, cc = c & 31, ob = rr * 64 + cc * 2; return st * 1024 + (ob ^ (((ob >> 9) & 1) << 5)); }
__host__ __device__ __forceinline__ void stage_rc(int b, int& R, int& C) { const int st = b / 1024, sb = b % 1024, swz = sb ^ (((sb >> 9) & 1) << 5); R = (st >> 1) * 16 + swz / 64; C = (st & 1) * 32 + (swz % 64) / 2; }
__host__ __device__ __forceinline__ int perm32(int rho) { const int n = rho >> 4, i = rho & 15; return 8 * (i >> 2) + 4 * n + (i & 3); }

struct Unit { int pm, pn; };
struct Gemm { const bf16_t* A; const bf16_t* Bt; int M, N, K, lda, apn2, ablk; };

struct StaticOrder {
    int nM, nN, nwg, G, c;
    __host__ __device__ void init(int M, int N, int G_, int c_) { nM = M / BM; nN = N / BM; nwg = nM * nN; G = G_; c = c_; }
    __host__ __device__ bool next(int i, Unit& u) const {
        const long L = (long)i * G + c; if (L >= nwg) return false;
        int wgid = (int)L; { const int q = nwg / NXCD, r = nwg % NXCD, xcd = wgid % NXCD, off = wgid / NXCD; wgid = (xcd < r ? xcd * (q + 1) : r * (q + 1) + (xcd - r) * q) + off; }
        const int nig = WGM * nN, gid = wgid / nig, fm = gid * WGM, gsz = (nM - fm) < WGM ? (nM - fm) : WGM;
        u.pm = fm + ((wgid % nig) % gsz); u.pn = (wgid % nig) / gsz; return true;
    }
    __device__ __forceinline__ void a_ready(const Unit&) const {}
    __device__ __forceinline__ void done(const Unit&) const {}
};

__device__ __forceinline__ unsigned cvt_pk_bf16(float lo, float hi) { unsigned r; asm volatile("v_cvt_pk_bf16_f32 %0, %1, %2" : "=v"(r) : "v"(lo), "v"(hi)); return r; }
typedef float f32x2 __attribute__((ext_vector_type(2)));

__device__ __forceinline__ float sigmoid_f(float v) { return __builtin_amdgcn_rcpf(1.0f + __builtin_amdgcn_exp2f(-1.4426950408889634f * v)); }
struct EpiBf16 {
    static constexpr bool PERM = true, AFTER_DRAIN = false;
    bf16_t* O; int ldc;
    __device__ __forceinline__ void operator()(const f32x4 (&acc)[2][2][4][2], const Unit& u, int wr, int wc, int fr, int fq) const {
        const int row0 = u.pm * BM + wr * 64 + fr, col0 = u.pn * BM + wc * 32 + 8 * fq;
#pragma unroll
        for (int ai = 0; ai < 2; ++ai)
#pragma unroll
            for (int m = 0; m < 4; ++m) { bf16_t* rowp = O + (size_t)(row0 + ai * HALF + m * 16) * ldc + col0;
#pragma unroll
                for (int bj = 0; bj < 2; ++bj) { const f32x4 v0 = acc[ai][bj][m][0], v1 = acc[ai][bj][m][1];
                    u32x4 w; w.x = cvt_pk_bf16(v0[0], v0[1]); w.y = cvt_pk_bf16(v0[2], v0[3]); w.z = cvt_pk_bf16(v1[0], v1[1]); w.w = cvt_pk_bf16(v1[2], v1[3]);
                    *(u32x4*)(rowp + bj * HALF) = w; } }
    }
};
struct EpiSwiglu {
    static constexpr bool PERM = true, AFTER_DRAIN = false;
    bf16_t* O; int ldc;
    __device__ __forceinline__ void operator()(const f32x4 (&acc)[2][2][4][2], const Unit& u, int wr, int wc, int fr, int fq) const {
        const int row0 = u.pm * BM + wr * 64 + fr, col0 = u.pn * HALF + wc * 32 + 8 * fq;
#pragma unroll
        for (int ai = 0; ai < 2; ++ai)
#pragma unroll
            for (int m = 0; m < 4; ++m) { bf16_t* rowp = O + ((size_t)(col0 >> 6) * 16384 + (size_t)(row0 + ai * HALF + m * 16)) * 64 + (col0 & 63);
                float h[8];
#pragma unroll
                for (int n = 0; n < 2; ++n)
#pragma unroll
                    for (int j = 0; j < 4; ++j) { const float g = acc[ai][0][m][n][j], up = acc[ai][1][m][n][j]; h[4 * n + j] = g * sigmoid_f(g) * up; }
                u32x4 w; w.x = cvt_pk_bf16(h[0], h[1]); w.y = cvt_pk_bf16(h[2], h[3]); w.z = cvt_pk_bf16(h[4], h[5]); w.w = cvt_pk_bf16(h[6], h[7]);
                *(u32x4*)rowp = w; }
    }
};
struct EpiResF32 {
    static constexpr bool PERM = false, AFTER_DRAIN = false;
    const float* base; float* out; int ldc; float alpha, s;
    __device__ __forceinline__ void operator()(const f32x4 (&acc)[2][2][4][2], const Unit& u, int wr, int wc, int fr, int fq) const {
        const int row0 = u.pm * BM + wr * 64 + fr, col0 = u.pn * BM + wc * 32 + 4 * fq;
#pragma unroll
        for (int ai = 0; ai < 2; ++ai)
#pragma unroll
            for (int m = 0; m < 4; ++m) { const size_t off = (size_t)(row0 + ai * HALF + m * 16) * ldc + col0;
#pragma unroll
                for (int bj = 0; bj < 2; ++bj)
#pragma unroll
                    for (int n = 0; n < 2; ++n) { f32x4 v = acc[ai][bj][m][n] * s; if (base) v += *(const f32x4*)(base + off + bj * HALF + n * 16) * alpha; *(f32x4*)(out + off + bj * HALF + n * 16) = v; } }
    }
};
template <bool BB> struct EpiResLn {
    static constexpr bool PERM = false, AFTER_DRAIN = true;
    const float* base; const bf16_t* baseb; float* zs; bf16_t* xb; int ldc; float alpha, s; const float* g; const float* b;
    unsigned long long* slots; unsigned* cnt; PG8_LAS unsigned char* xl;
    typedef float f32x2v __attribute__((ext_vector_type(2))); typedef unsigned u32x2v __attribute__((ext_vector_type(2)));
    typedef typename std::conditional<BB, u32x2v, f32x4>::type bvec;
    __device__ __forceinline__ bvec ldb(size_t o) const { if constexpr (BB) return __builtin_nontemporal_load((const u32x2v*)(baseb + o)); else return __builtin_nontemporal_load((const f32x4*)(base + o)); }
    static __device__ __forceinline__ f32x4 cvb(const bvec& v) { if constexpr (BB) return (f32x4){__uint_as_float(v.x << 16), __uint_as_float(v.x & 0xffff0000u), __uint_as_float(v.y << 16), __uint_as_float(v.y & 0xffff0000u)}; else return v; }
    __device__ __forceinline__ void first(const f32x4 (&acc)[2][2][4][2], const Unit& u, int wr, int wc, int fr, int fq) const {
        PG8_LAS f32x2v* SAp = (PG8_LAS f32x2v*)xl;
        const int row0 = u.pm * BM + wr * 64 + fr, col0 = u.pn * BM + wc * 32 + 4 * fq;
#pragma unroll
        for (int ai = 0; ai < 2; ++ai) { bvec bv[4][4];
#pragma unroll
            for (int m = 0; m < 4; ++m)
#pragma unroll
                for (int q = 0; q < 4; ++q) bv[m][q] = ldb((size_t)(row0 + ai * HALF + m * 16) * ldc + col0 + (q >> 1) * HALF + (q & 1) * 16);
#pragma unroll
            for (int m = 0; m < 4; ++m) { const size_t off = (size_t)(row0 + ai * HALF + m * 16) * ldc + col0; float s1 = 0.f, s2 = 0.f;
#pragma unroll
                for (int q = 0; q < 4; ++q) { const f32x4 v = acc[ai][q >> 1][m][q & 1] * s + cvb(bv[m][q]) * alpha; *(f32x4*)(zs + off + (q >> 1) * HALF + (q & 1) * 16) = v;
                    s1 += (v[0] + v[1]) + (v[2] + v[3]); s2 += (v[0] * v[0] + v[1] * v[1]) + (v[2] * v[2] + v[3] * v[3]); }
                s1 += __shfl_xor(s1, 16); s1 += __shfl_xor(s1, 32); s2 += __shfl_xor(s2, 16); s2 += __shfl_xor(s2, 32);
                if (fq == 0) SAp[(ai * HALF + wr * 64 + m * 16 + fr) * 4 + wc] = (f32x2v){s1, s2}; }
            asm volatile("" ::: "memory"); }
    }
    __device__ __forceinline__ void fused(f32x4 (&acc)[2][2][4][2], const Unit& u, int wr, int wc, int fr, int fq, PG8_LAS unsigned char* lds, int wid, int lane) const {
        PG8_LAS f32x2v* P = (PG8_LAS f32x2v*)lds;
        PG8_LAS f32x2v* SAp = (PG8_LAS f32x2v*)xl;
        PG8_LAS f32x2v* St = (PG8_LAS f32x2v*)(lds + 8192);
        const int row0 = u.pm * BM + wr * 64 + fr, col0 = u.pn * BM + wc * 32 + 4 * fq;
#pragma unroll
        for (int ai = 0; ai < 2; ++ai) { bvec bv[4][4];
#pragma unroll
            for (int m = 0; m < 4; ++m)
#pragma unroll
                for (int q = 0; q < 4; ++q) bv[m][q] = ldb((size_t)(row0 + ai * HALF + m * 16) * ldc + col0 + (q >> 1) * HALF + (q & 1) * 16);
#pragma unroll
            for (int m = 0; m < 4; ++m) { float s1 = 0.f, s2 = 0.f;
#pragma unroll
                for (int q = 0; q < 4; ++q) { const f32x4 v = acc[ai][q >> 1][m][q & 1] * s + cvb(bv[m][q]) * alpha; acc[ai][q >> 1][m][q & 1] = v;
                    s1 += (v[0] + v[1]) + (v[2] + v[3]); s2 += (v[0] * v[0] + v[1] * v[1]) + (v[2] * v[2] + v[3] * v[3]); }
                s1 += __shfl_xor(s1, 16); s1 += __shfl_xor(s1, 32); s2 += __shfl_xor(s2, 16); s2 += __shfl_xor(s2, 32);
                if (fq == 0) P[(ai * HALF + wr * 64 + m * 16 + fr) * 4 + wc] = (f32x2v){s1, s2}; }
            asm volatile("" ::: "memory"); }
        asm volatile("s_waitcnt lgkmcnt(0)" ::: "memory"); __builtin_amdgcn_s_barrier(); asm volatile("" ::: "memory");
        const int row = wid * 32 + (lane & 31);
        if (lane < 32) { float su = 0.f, sq = 0.f;
#pragma unroll
            for (int k = 0; k < 4; ++k) { const f32x2v a = P[row * 4 + k], c = SAp[row * 4 + k]; su += a.x + c.x; sq += a.y + c.y; }
            __hip_atomic_store(slots + ((size_t)(u.pm * BM + row) * 4 + (u.pn & 3)), ((unsigned long long)__float_as_uint(sq) << 32) | __float_as_uint(su), __ATOMIC_RELAXED, __HIP_MEMORY_SCOPE_AGENT); }
        asm volatile("s_waitcnt vmcnt(0)" ::: "memory");
        if (lane == 0) __hip_atomic_fetch_add(cnt + 64 * u.pm, 1u, __ATOMIC_RELAXED, __HIP_MEMORY_SCOPE_AGENT);
        if (wid == 0) { unsigned spins = 0;
            while ((unsigned)__builtin_amdgcn_readfirstlane(__hip_atomic_load(cnt + 64 * u.pm, __ATOMIC_RELAXED, __HIP_MEMORY_SCOPE_AGENT)) < 32u && ++spins < (1u << 22)) __builtin_amdgcn_s_sleep(2);
            __builtin_amdgcn_fence(__ATOMIC_ACQUIRE, "agent"); }
        asm volatile("s_waitcnt vmcnt(0) lgkmcnt(0)" ::: "memory"); __builtin_amdgcn_s_barrier(); asm volatile("" ::: "memory");
        if (lane < 32) { float su = 0.f, sq = 0.f; const unsigned long long* sl = slots + (size_t)(u.pm * BM + row) * 4;
#pragma unroll
            for (int k = 0; k < 4; ++k) { const unsigned long long w = __hip_atomic_load(sl + k, __ATOMIC_RELAXED, __HIP_MEMORY_SCOPE_AGENT); su += __uint_as_float((unsigned)w); sq += __uint_as_float((unsigned)(w >> 32)); }
            const float mean = su * (1.0f / 2048.0f), var = fmaxf(sq * (1.0f / 2048.0f) - mean * mean, 0.f);
            St[row] = (f32x2v){mean, 1.0f / sqrtf(var + 1e-5f)}; }
        asm volatile("s_waitcnt lgkmcnt(0)" ::: "memory"); __builtin_amdgcn_s_barrier(); asm volatile("" ::: "memory");
        { f32x4 gg[4], bb[4];
#pragma unroll
          for (int q = 0; q < 4; ++q) { gg[q] = *(const f32x4*)(g + col0 + (q >> 1) * HALF + (q & 1) * 16); bb[q] = *(const f32x4*)(b + col0 + (q >> 1) * HALF + (q & 1) * 16); }
#pragma unroll
          for (int ai = 0; ai < 2; ++ai)
#pragma unroll
            for (int m = 0; m < 4; ++m) { const int r = ai * HALF + wr * 64 + m * 16 + fr; const f32x2v sr = St[r]; const size_t off = (size_t)(u.pm * BM + r) * ldc + col0;
#pragma unroll
                for (int q = 0; q < 4; ++q) { const size_t o2 = off + (q >> 1) * HALF + (q & 1) * 16; const f32x4 y = (acc[ai][q >> 1][m][q & 1] - sr.x) * sr.y * gg[q] + bb[q];
                    *(u32x2v*)(xb + o2) = (u32x2v){cvt_pk_bf16(y[0], y[1]), cvt_pk_bf16(y[2], y[3])}; } } }
        asm volatile("" ::: "memory");
        { const int colA = col0 - 1024; f32x4 gg[4], bb[4];
#pragma unroll
          for (int q = 0; q < 4; ++q) { gg[q] = *(const f32x4*)(g + colA + (q >> 1) * HALF + (q & 1) * 16); bb[q] = *(const f32x4*)(b + colA + (q >> 1) * HALF + (q & 1) * 16); }
#pragma unroll
          for (int ai = 0; ai < 2; ++ai) { f32x4 zv[4][4];
#pragma unroll
            for (int m = 0; m < 4; ++m)
#pragma unroll
                for (int q = 0; q < 4; ++q) zv[m][q] = __builtin_nontemporal_load((const f32x4*)(zs + (size_t)(u.pm * BM + ai * HALF + wr * 64 + m * 16 + fr) * ldc + colA + (q >> 1) * HALF + (q & 1) * 16));
#pragma unroll
            for (int m = 0; m < 4; ++m) { const int r = ai * HALF + wr * 64 + m * 16 + fr; const f32x2v sr = St[r]; const size_t off = (size_t)(u.pm * BM + r) * ldc + colA;
#pragma unroll
                for (int q = 0; q < 4; ++q) { const size_t o2 = off + (q >> 1) * HALF + (q & 1) * 16; const f32x4 y = (zv[m][q] - sr.x) * sr.y * gg[q] + bb[q];
                    *(u32x2v*)(xb + o2) = (u32x2v){cvt_pk_bf16(y[0], y[1]), cvt_pk_bf16(y[2], y[3])}; } }
            asm volatile("" ::: "memory"); } }
    }
};
struct EpiPle {
    static constexpr bool PERM = false, AFTER_DRAIN = false;
    const bf16_t* x3; float* xo; const bf16_t* pp; int ldc;
    typedef unsigned u32x2p __attribute__((ext_vector_type(2)));
    __device__ __forceinline__ void operator()(const f32x4 (&acc)[2][2][4][2], const Unit& u, int wr, int wc, int fr, int fq) const {
        const int row0 = u.pm * BM + wr * 64 + fr, col0 = u.pn * BM + wc * 32 + 4 * fq;
#pragma unroll
        for (int ai = 0; ai < 2; ++ai)
#pragma unroll
            for (int mp = 0; mp < 2; ++mp) { u32x2p xv[2][4], pv[2][4];
#pragma unroll
                for (int mm = 0; mm < 2; ++mm)
#pragma unroll
                    for (int q = 0; q < 4; ++q) { const size_t o2 = (size_t)(row0 + ai * HALF + (2 * mp + mm) * 16) * ldc + col0 + (q >> 1) * HALF + (q & 1) * 16; xv[mm][q] = *(const u32x2p*)(x3 + o2); pv[mm][q] = __builtin_nontemporal_load((const u32x2p*)(pp + o2)); }
#pragma unroll
                for (int mm = 0; mm < 2; ++mm)
#pragma unroll
                    for (int q = 0; q < 4; ++q) { const int m = 2 * mp + mm; const size_t o2 = (size_t)(row0 + ai * HALF + m * 16) * ldc + col0 + (q >> 1) * HALF + (q & 1) * 16;
                        const f32x4 a = acc[ai][q >> 1][m][q & 1]; const u32x2p xw = xv[mm][q], pw = pv[mm][q];
                        const f32x4 p = {__uint_as_float(pw.x << 16), __uint_as_float(pw.x & 0xffff0000u), __uint_as_float(pw.y << 16), __uint_as_float(pw.y & 0xffff0000u)};
                        f32x4 r; r[0] = __uint_as_float(xw.x << 16) + sigmoid_f(a[0]) * p[0]; r[1] = __uint_as_float(xw.x & 0xffff0000u) + sigmoid_f(a[1]) * p[1];
                        r[2] = __uint_as_float(xw.y << 16) + sigmoid_f(a[2]) * p[2]; r[3] = __uint_as_float(xw.y & 0xffff0000u) + sigmoid_f(a[3]) * p[3];
                        *(f32x4*)(xo + o2) = r; }
                asm volatile("" ::: "memory"); }
    }
};
__device__ __forceinline__ float gelu_tanh_f(float x) { const float y = 0.7978845608028654f * (x + 0.044715f * x * x * x); const float t = 1.0f - 2.0f * __builtin_amdgcn_rcpf(1.0f + __builtin_amdgcn_exp2f(2.8853900817779268f * y)); return 0.5f * x * (1.0f + t); }
struct EpiInProj {
    static constexpr bool PERM = true, AFTER_DRAIN = false;
    bf16_t* Hb; const int* pos;
    __device__ __forceinline__ void operator()(const f32x4 (&acc)[2][2][4][2], const Unit& u, int wr, int wc, int fr, int fq) const {
        constexpr float INVF[16] = {1.000000000e+00f, 4.403665960e-01f, 1.939227432e-01f, 8.539710194e-02f, 3.760603070e-02f, 1.656043902e-02f, 7.292664610e-03f, 3.211445874e-03f,
                                    1.414213562e-03f, 6.227723788e-04f, 2.742481884e-04f, 1.207697351e-04f, 5.318296098e-05f, 2.341999971e-05f, 1.031338616e-05f, 4.541670478e-06f};
        const int pn = u.pn, row0 = u.pm * BM + wr * 64 + fr, cw = wc * 32 + 8 * fq;
        if (pn >= 16) {
#pragma unroll
            for (int ai = 0; ai < 2; ++ai)
#pragma unroll
                for (int m = 0; m < 4; ++m) { const int row = row0 + ai * HALF + m * 16;
#pragma unroll
                    for (int bj = 0; bj < 2; ++bj) { const int ch0 = (pn - 16) * 256 + bj * HALF + cw;
                        bf16_t* p = Hb + (size_t)16384 * 4096 + ((size_t)((row >> 13) * 96 + (ch0 >> 4)) * 8192 + (row & 8191)) * 16 + (ch0 & 15);
                        float h[8];
#pragma unroll
                        for (int e = 0; e < 8; ++e) h[e] = gelu_tanh_f(acc[ai][bj][m][e >> 2][e & 3]);
                        u32x4 w; w.x = cvt_pk_bf16(h[0], h[1]); w.y = cvt_pk_bf16(h[2], h[3]); w.z = cvt_pk_bf16(h[4], h[5]); w.w = cvt_pk_bf16(h[6], h[7]); *(u32x4*)p = w; } }
            return;
        }
        bf16_t* base; int ld, c0;
        if (pn < 6) { base = Hb; ld = 1536; c0 = pn * 256; }
        else if (pn < 8) { base = Hb + (size_t)16384 * 1536; ld = 512; c0 = (pn - 6) * 256; }
        else if (pn < 10) { base = Hb + (size_t)16384 * 2048; ld = 512; c0 = (pn - 8) * 256; }
        else { base = Hb + (size_t)16384 * 2560; ld = 1536; c0 = (pn - 10) * 256; }
        const bool rot = (pn < 8) && (wc == 0);
        const float sgn = (fq < 2) ? -1.0f : 1.0f;
#pragma unroll
        for (int ai = 0; ai < 2; ++ai)
#pragma unroll
            for (int m = 0; m < 4; ++m) { const int row = row0 + ai * HALF + m * 16; bf16_t* rowp = base + (size_t)row * ld + c0 + cw;
                float cs[8], sn[8];
                if (rot) { const float ps = (float)pos[row];
#pragma unroll
                    for (int e = 0; e < 8; ++e) { const float ang = ps * ((fq & 1) ? INVF[8 + e] : INVF[e]); const float kq = rintf(ang * 0.15915494309189535f);
                        float r1 = fmaf(-kq, 6.28125f, ang); r1 = fmaf(-kq, 1.9353071795864769e-3f, r1); cs[e] = __cosf(r1); sn[e] = __sinf(r1) * sgn; } }
#pragma unroll
                for (int bj = 0; bj < 2; ++bj) { float v[8];
#pragma unroll
                    for (int e = 0; e < 8; ++e) v[e] = acc[ai][bj][m][e >> 2][e & 3];
                    if (rot) {
#pragma unroll
                        for (int e = 0; e < 8; ++e) { const float pt = __shfl_xor(v[e], 32); v[e] = v[e] * cs[e] + pt * sn[e]; } }
                    u32x4 w; w.x = cvt_pk_bf16(v[0], v[1]); w.y = cvt_pk_bf16(v[2], v[3]); w.z = cvt_pk_bf16(v[4], v[5]); w.w = cvt_pk_bf16(v[6], v[7]);
                    *(u32x4*)(rowp + bj * HALF) = w; } }
    }
};
struct EpiLru {
    static constexpr bool PERM = true, AFTER_DRAIN = false;
    const bf16_t* xc; bf16_t* la; bf16_t* uo; const float* br; const float* bi; const float* sp;
    __device__ __forceinline__ void operator()(const f32x4 (&acc)[2][2][4][2], const Unit& u, int wr, int wc, int fr, int fq) const {
        const int row0 = u.pm * BM + wr * 64 + fr, ch0 = u.pn * HALF + wc * 32 + 8 * fq;
#pragma unroll
        for (int ai = 0; ai < 2; ++ai)
#pragma unroll
            for (int m = 0; m < 4; ++m) { const int row = row0 + ai * HALF + m * 16; const size_t off = (size_t)row * 1536 + ch0;
                const size_t ob = ((size_t)((row >> 13) * 96 + (ch0 >> 4)) * 8192 + (row & 8191)) * 16 + (ch0 & 15);
                const u32x4 xv = *(const u32x4*)(xc + off); unsigned lw[4], uw[4];
#pragma unroll
                for (int n = 0; n < 2; ++n) { const f32x4 brv = *(const f32x4*)(br + ch0 + 4 * n), biv = *(const f32x4*)(bi + ch0 + 4 * n), spv = *(const f32x4*)(sp + ch0 + 4 * n); float lv[4], uv[4];
#pragma unroll
                    for (int j = 0; j < 4; ++j) { const unsigned xw = xv[2 * n + (j >> 1)]; const float x = __uint_as_float((j & 1) ? (xw & 0xffff0000u) : (xw << 16));
                        const float r = sigmoid_f(acc[ai][0][m][n][j] + brv[j]), ig = sigmoid_f(acc[ai][1][m][n][j] + biv[j]);
                        const float l = spv[j] * r, a = __expf(l); lv[j] = 1.0f - a; uv[j] = __builtin_amdgcn_sqrtf(fmaxf(1.0f - a * a, 0.f)) * (ig * x); }
                    lw[2 * n] = cvt_pk_bf16(lv[0], lv[1]); lw[2 * n + 1] = cvt_pk_bf16(lv[2], lv[3]); uw[2 * n] = cvt_pk_bf16(uv[0], uv[1]); uw[2 * n + 1] = cvt_pk_bf16(uv[2], uv[3]); }
                *(u32x4*)(la + ob) = (u32x4){lw[0], lw[1], lw[2], lw[3]}; *(u32x4*)(uo + ob) = (u32x4){uw[0], uw[1], uw[2], uw[3]};
                asm volatile("" ::: "memory"); }
    }
};

template <class Epi, class Sched, bool ALIGN_EPI = false, bool SP2 = false>
__device__ __forceinline__ void gemm_phase(PG8_LAS unsigned char* lds, const Gemm g, const Sched& S, const Epi& E) {
    int tid_ = threadIdx.x; asm volatile("" : "+v"(tid_));
    const int tid = tid_, wid = __builtin_amdgcn_readfirstlane(tid >> 6), lane = tid & 63, wr = wid >> 2, wc = wid & 3, fr = lane & 15, fq = lane >> 4;
    const int K = g.K, nt = K / BK;
    unsigned voffA[2], voffB[2];
#pragma unroll
    for (int i = 0; i < 2; ++i) { int R, C; stage_rc(tid * 16 + i * 8192, R, C); const int Rb = Epi::PERM ? ((R & ~31) + perm32(R & 31)) : R;
        voffA[i] = g.ablk == 2 ? (unsigned)(R * 64 + C) * 2u : g.ablk ? (unsigned)((C >> 4) * (8192 * 16) + R * 16 + (C & 15)) * 2u : (unsigned)(R * g.lda + C) * 2u; voffB[i] = (unsigned)(Rb * K + C) * 2u; }
    const size_t kstepB = (size_t)(BK * 2), kstepA = g.ablk == 2 ? (size_t)g.M * 64 * 2 : g.ablk ? (size_t)4 * 8192 * 16 * 2 : (size_t)(BK * 2);
    const size_t hstepA = g.ablk == 2 ? (size_t)HALF * 64 * 2 : g.ablk ? (size_t)HALF * 16 * 2 : (size_t)HALF * g.lda * 2, hstepB = (size_t)HALF * K * 2;
    const size_t tstepA = 2 * hstepA, tstepB = 2 * hstepB;
    const unsigned ldsw = (unsigned)wid * 1024u;
    const int aoff = lds_byte(wr * 64 + fr, fq * 8), boff = lds_byte(wc * 32 + fr, fq * 8);
#define PG8_SA(b, h) (((b) * 2 + (h)) * HTB)
#define PG8_SB(b, h) ((4 + (b) * 2 + (h)) * HTB)
#define PG8_STAGE(bufoff, gbase, voff) do { _Pragma("unroll") for (int _i = 0; _i < 2; ++_i) \
        __builtin_amdgcn_global_load_lds((const unsigned*)((const char*)(gbase) + (voff)[_i]), (PG8_LAS unsigned*)(lds + (bufoff) + ldsw + _i * 8192), 16, 0, 0); } while (0)
#define PG8_LDA(dst, b, h) do { _Pragma("unroll") for (int m = 0; m < 4; ++m) _Pragma("unroll") for (int k = 0; k < 2; ++k) dst[m][k] = *(const PG8_LAS bf16x8*)(lds + PG8_SA(b, h) + aoff + m * 2048 + k * 1024); } while (0)
#define PG8_LDB(dst, b, h) do { _Pragma("unroll") for (int n = 0; n < 2; ++n) _Pragma("unroll") for (int k = 0; k < 2; ++k) dst[n][k] = *(const PG8_LAS bf16x8*)(lds + PG8_SB(b, h) + boff + n * 2048 + k * 1024); } while (0)
#define PG8_MMA(ai, bj, At, Bt) do { __builtin_amdgcn_s_setprio(1); _Pragma("unroll") for (int m = 0; m < 4; ++m) _Pragma("unroll") for (int n = 0; n < 2; ++n) _Pragma("unroll") for (int k = 0; k < 2; ++k) \
        acc[ai][bj][m][n] = __builtin_amdgcn_mfma_f32_16x16x32_bf16(Bt[n][k], At[m][k], acc[ai][bj][m][n], 0, 0, 0); __builtin_amdgcn_s_setprio(0); } while (0)
#define PG8_WAIT_V(n) asm volatile("s_waitcnt vmcnt(" #n ")" ::: "memory")
#define PG8_WAIT_L(n) asm volatile("s_waitcnt lgkmcnt(" #n ")" ::: "memory")
#define PG8_BAR __builtin_amdgcn_s_barrier()
#define PG8_SCHED __builtin_amdgcn_sched_barrier(0)
    Unit cur, nxt; int ui = 0;
    if (!S.next(0, cur)) return;
    f32x4 acc[2][2][4][2];
#pragma unroll
    for (int a = 0; a < 2; ++a)
#pragma unroll
        for (int b = 0; b < 2; ++b)
#pragma unroll
            for (int m = 0; m < 4; ++m)
#pragma unroll
                for (int n = 0; n < 2; ++n) acc[a][b][m][n] = (f32x4){0.f, 0.f, 0.f, 0.f};
    bf16x8 At[4][2], B0[2][2], B1[2][2];
    const char* cA = (const char*)g.A + (g.ablk == 2 ? (size_t)cur.pm * 256 * 64 * 2 : g.ablk ? ((size_t)(cur.pm >> 5) * 128 * 8192 * 16 + (size_t)(cur.pm & 31) * 256 * 16) * 2 : (size_t)cur.pm * tstepA + (size_t)(cur.pn >> 1) * g.apn2 * 2); const char* cB = (const char*)g.Bt + (size_t)cur.pn * tstepB;
    S.a_ready(cur);
    if constexpr (SP2) {
        PG8_STAGE(PG8_SB(0, 0), cB, voffB); PG8_STAGE(PG8_SB(0, 1), cB + hstepB, voffB); PG8_STAGE(PG8_SA(0, 0), cA, voffA); PG8_STAGE(PG8_SA(0, 1), cA + hstepA, voffA);
        if (wr == 1) PG8_BAR;
        PG8_WAIT_V(2); PG8_BAR;
        PG8_STAGE(PG8_SB(1, 0), cB + kstepB, voffB); PG8_STAGE(PG8_SA(1, 0), cA + kstepA, voffA); PG8_STAGE(PG8_SB(1, 1), cB + hstepB + kstepB, voffB);
        PG8_WAIT_V(6); PG8_BAR;
    } else {
        PG8_STAGE(PG8_SB(0, 0), cB, voffB); PG8_STAGE(PG8_SA(0, 0), cA, voffA); PG8_STAGE(PG8_SB(0, 1), cB + hstepB, voffB); PG8_STAGE(PG8_SA(0, 1), cA + hstepA, voffA);
        if (wr == 1) PG8_BAR;
        PG8_WAIT_V(4); PG8_BAR;
        PG8_STAGE(PG8_SB(1, 0), cB + kstepB, voffB); PG8_STAGE(PG8_SA(1, 0), cA + kstepA, voffA); PG8_STAGE(PG8_SB(1, 1), cB + hstepB + kstepB, voffB);
        PG8_WAIT_V(6); PG8_BAR;
    }
    for (;;) {
        const bool has_next = S.next(ui + 1, nxt);
        const char* nA = has_next ? (const char*)g.A + (g.ablk == 2 ? (size_t)nxt.pm * 256 * 64 * 2 : g.ablk ? ((size_t)(nxt.pm >> 5) * 128 * 8192 * 16 + (size_t)(nxt.pm & 31) * 256 * 16) * 2 : (size_t)nxt.pm * tstepA + (size_t)(nxt.pn >> 1) * g.apn2 * 2) : cA; const char* nB = has_next ? (const char*)g.Bt + (size_t)nxt.pn * tstepB : cB;
        for (int t = 0; t < nt; t += 2) {
            const bool last = (t == nt - 2);
            const char* a1 = cA + (size_t)(t + 1) * kstepA;
            const char* a2 = last ? nA : cA + (size_t)(t + 2) * kstepA; const char* b2 = last ? nB : cB + (size_t)(t + 2) * kstepB;
            const char* a3 = a2 + kstepA; const char* b3 = b2 + kstepB;
            if (last && has_next) S.a_ready(nxt);
            if constexpr (SP2) {
            PG8_LDB(B0, 0, 0); PG8_LDB(B1, 0, 1); PG8_SCHED; PG8_LDA(At, 0, 0); PG8_STAGE(PG8_SA(1, 1), a1 + hstepA, voffA);
            PG8_WAIT_V(8); PG8_WAIT_L(0); PG8_BAR; PG8_MMA(0, 0, At, B0); PG8_MMA(0, 1, At, B1); PG8_BAR; PG8_SCHED;
            PG8_LDA(At, 0, 1); PG8_STAGE(PG8_SB(0, 0), b2, voffB); PG8_STAGE(PG8_SB(0, 1), b2 + hstepB, voffB); PG8_STAGE(PG8_SA(0, 0), a2, voffA);
            PG8_WAIT_V(8); PG8_WAIT_L(0); PG8_BAR; PG8_MMA(1, 0, At, B0); PG8_MMA(1, 1, At, B1); PG8_BAR; PG8_SCHED;
            PG8_LDB(B0, 1, 0); PG8_LDB(B1, 1, 1); PG8_SCHED; PG8_LDA(At, 1, 0); PG8_STAGE(PG8_SA(0, 1), a2 + hstepA, voffA);
            PG8_WAIT_V(8); PG8_WAIT_L(0); PG8_BAR; PG8_MMA(0, 0, At, B0); PG8_MMA(0, 1, At, B1); PG8_BAR; PG8_SCHED;
            PG8_LDA(At, 1, 1); PG8_STAGE(PG8_SB(1, 0), b3, voffB); PG8_STAGE(PG8_SB(1, 1), b3 + hstepB, voffB); PG8_STAGE(PG8_SA(1, 0), a3, voffA);
            PG8_WAIT_V(8); PG8_WAIT_L(0); PG8_BAR; PG8_MMA(1, 0, At, B0); PG8_MMA(1, 1, At, B1); PG8_BAR; PG8_SCHED;
            } else {
            PG8_LDB(B0, 0, 0); PG8_SCHED; PG8_LDA(At, 0, 0); PG8_STAGE(PG8_SA(1, 1), a1 + hstepA, voffA);
            PG8_WAIT_L(8); PG8_BAR; PG8_WAIT_L(0); PG8_MMA(0, 0, At, B0); PG8_BAR; PG8_SCHED;
            PG8_LDB(B1, 0, 1); PG8_STAGE(PG8_SB(0, 0), b2, voffB);
            PG8_BAR; PG8_WAIT_L(0); PG8_MMA(0, 1, At, B1); PG8_BAR;
            PG8_LDA(At, 0, 1); PG8_STAGE(PG8_SA(0, 0), a2, voffA);
            PG8_BAR; PG8_WAIT_L(0); PG8_MMA(1, 0, At, B0); PG8_BAR; PG8_SCHED;
            PG8_STAGE(PG8_SB(0, 1), b2 + hstepB, voffB);
            PG8_WAIT_V(6); PG8_BAR; PG8_MMA(1, 1, At, B1); PG8_BAR;
            PG8_LDB(B0, 1, 0); PG8_SCHED; PG8_LDA(At, 1, 0); PG8_STAGE(PG8_SA(0, 1), a2 + hstepA, voffA);
            PG8_WAIT_L(8); PG8_BAR; PG8_WAIT_L(0); PG8_MMA(0, 0, At, B0); PG8_BAR; PG8_SCHED;
            PG8_LDB(B1, 1, 1); PG8_STAGE(PG8_SB(1, 0), b3, voffB);
            PG8_BAR; PG8_WAIT_L(0); PG8_MMA(0, 1, At, B1); PG8_BAR;
            PG8_LDA(At, 1, 1); PG8_STAGE(PG8_SA(1, 0), a3, voffA);
            PG8_BAR; PG8_WAIT_L(0); PG8_MMA(1, 0, At, B0); PG8_BAR; PG8_SCHED;
            PG8_STAGE(PG8_SB(1, 1), b3 + hstepB, voffB);
            PG8_WAIT_V(6); PG8_BAR; PG8_MMA(1, 1, At, B1); PG8_BAR;
            }
        }
        if constexpr (ALIGN_EPI) { if (wr == 0) PG8_BAR; }
        if constexpr (!Epi::AFTER_DRAIN) { E(acc, cur, wr, wc, fr, fq); S.done(cur); } else { if (has_next) E.first(acc, cur, wr, wc, fr, fq); }
        if (!has_next) break;
#pragma unroll
        for (int a = 0; a < 2; ++a)
#pragma unroll
            for (int b = 0; b < 2; ++b)
#pragma unroll
                for (int m = 0; m < 4; ++m)
#pragma unroll
                    for (int n = 0; n < 2; ++n) acc[a][b][m][n] = (f32x4){0.f, 0.f, 0.f, 0.f};
        cur = nxt; cA = nA; cB = nB; ++ui;
        if constexpr (ALIGN_EPI) { if (wr == 1) PG8_BAR; }
    }
    PG8_WAIT_V(0);
    if constexpr (!ALIGN_EPI) { if (wr == 0) PG8_BAR; }
    PG8_BAR;
    if constexpr (Epi::AFTER_DRAIN) { E.fused(acc, cur, wr, wc, fr, fq, lds, wid, lane); S.done(cur); }
#undef PG8_SA
#undef PG8_SB
#undef PG8_STAGE
#undef PG8_LDA
#undef PG8_LDB
#undef PG8_MMA
#undef PG8_WAIT_V
#undef PG8_WAIT_L
#undef PG8_BAR
#undef PG8_SCHED
}
}

constexpr int NWAVES = 8, NTHREADS = NWAVES * 64;
constexpr int SEQ = 8192, NB = 2, M = NB * SEQ, D = 2048, FF = 5632, NIN = 5632, LW = 1536;
constexpr size_t SEC_K = (size_t)16384 * 1536, SEC_V = (size_t)16384 * 2048, SEC_XB = (size_t)16384 * 2560, SEC_YG = (size_t)16384 * 4096;
constexpr float LN_EPS = 1e-5f, ALPHA = 1.189207115002721f;
constexpr size_t MiB = 1u << 20;
constexpr size_t WS_BAR = 0, WS_CNT = 65536  , WS_LSE = 1 * MiB, WS_SP = 2 * MiB, WS_SLOT = 2 * MiB + 262144  , WS_TS = 4 * MiB - 65536;
constexpr size_t WS_WFGU = 4 * MiB, WS_WFD = 48 * MiB;
constexpr size_t WS_WIN = 70 * MiB, WS_WOUT = 92 * MiB, WS_WPG = 100 * MiB, WS_WPP = 108 * MiB, WS_WRG = 109 * MiB, WS_PB = 111 * MiB;
constexpr size_t WS_XB = 120 * MiB;
constexpr size_t WS_H = 184 * MiB;
constexpr size_t WS_XC = 360 * MiB, WS_LA = 408 * MiB, WS_U = 456 * MiB, WS_END = 504 * MiB;
constexpr int LDS_BYTES = 147456;

#define LAS __attribute__((address_space(3)))
typedef unsigned short bf16;
typedef unsigned v4u __attribute__((ext_vector_type(4)));
typedef unsigned v2u __attribute__((ext_vector_type(2)));
typedef float f32x4 __attribute__((ext_vector_type(4)));
#define LDS_WAIT() asm volatile("s_waitcnt lgkmcnt(0)" ::: "memory")
__device__ __forceinline__ unsigned f2bf(float f) { unsigned u = __builtin_bit_cast(unsigned, f); return (u + 0x7fffu + ((u >> 16) & 1u)) >> 16; }
__device__ __forceinline__ unsigned pk2(float lo, float hi) { return f2bf(lo) | (f2bf(hi) << 16); }
__device__ __forceinline__ float bflo(unsigned w) { return __uint_as_float(w << 16); }
__device__ __forceinline__ float bfhi(unsigned w) { return __uint_as_float(w & 0xffff0000u); }
__device__ __forceinline__ float bf1(bf16 h) { return __uint_as_float((unsigned)h << 16); }
__device__ __forceinline__ float wave_sum(float v) {
#pragma unroll
    for (int o = 1; o < 64; o <<= 1) v += __shfl_xor(v, o);
    return v;
}
__device__ __forceinline__ float wave_max(float v) {
#pragma unroll
    for (int o = 1; o < 64; o <<= 1) v = fmaxf(v, __shfl_xor(v, o));
    return v;
}
__device__ __forceinline__ float gelu_tanh(float x) {
    const float y = 0.7978845608028654f * (x + 0.044715f * x * x * x);
    const float t = 1.0f - 2.0f * __builtin_amdgcn_rcpf(1.0f + __expf(2.0f * y));
    return 0.5f * x * (1.0f + t);
}

struct Args { const float* in[26]; float* out; unsigned char* ws; int ph_lo, ph_hi; };

__device__ __forceinline__ void tr_item(const float* W, int N, int k0, int n0, bf16* WT, int drow0, int ldt, int dcol0, LAS float* scr, int lane) {
    float tv[32];
#pragma unroll
    for (int i = 0; i < 32; ++i) tv[i] = __builtin_nontemporal_load(&W[(size_t)(k0 + 2 * i + (lane >> 5)) * N + n0 + (lane & 31)]);
#pragma unroll
    for (int i = 0; i < 32; ++i) scr[(2 * i + (lane >> 5)) * 33 + (lane & 31)] = tv[i];
    LDS_WAIT(); asm volatile("" ::: "memory");
    const int c = lane & 7;
#pragma unroll
    for (int j = 0; j < 4; ++j) { const int n = (lane >> 3) + 8 * j; const LAS float* s = scr + (8 * c) * 33 + n;
        v4u o; o.x = pk2(s[0 * 33], s[1 * 33]); o.y = pk2(s[2 * 33], s[3 * 33]); o.z = pk2(s[4 * 33], s[5 * 33]); o.w = pk2(s[6 * 33], s[7 * 33]);
        *(v4u*)(WT + (size_t)(drow0 + n) * ldt + dcol0 + 8 * c) = o; }
    LDS_WAIT(); asm volatile("" ::: "memory");
}
__device__ __forceinline__ void tr_matrix_item(const float* W, int K, int N, bf16* WT, int mode, int item, LAS float* scr, int lane) {
    const int nblk = N / 32, kb = item / nblk, nb = item % nblk, k0 = 64 * kb, n0 = 32 * nb;
    int drow0 = n0; if (mode) drow0 = 256 * (n0 >> 7) + (n0 & 127) + (mode == 2 ? 128 : 0);
    tr_item(W, N, k0, n0, WT, drow0, K, k0, scr, lane);
}
constexpr int IT_FF = (D / 64) * (FF / 32);
__device__ __forceinline__ void convert_ffn(const float* wg, const float* wu, const float* wd, unsigned char* ws, LAS float* scr, int it_lo, int it_hi, int gw, int NGW, int lane) {
    for (int it = it_lo + gw; it < it_hi; it += NGW) {
        int r = it;
        if (r < IT_FF) { tr_matrix_item(wg, D, FF, (bf16*)(ws + WS_WFGU), 1, r, scr, lane); continue; } r -= IT_FF;
        if (r < IT_FF) { tr_matrix_item(wu, D, FF, (bf16*)(ws + WS_WFGU), 2, r, scr, lane); continue; } r -= IT_FF;
        tr_matrix_item(wd, FF, D, (bf16*)(ws + WS_WFD), 0, r, scr, lane);
    }
}
__device__ __forceinline__ void convert_rest(const Args& a, LAS float* scr, int gw, int NGW, int lane) {
    unsigned char* ws = a.ws;
    constexpr int I_IN = IT_FF, I_SQ = (D / 64) * (D / 32), I_PP = (256 / 64) * (D / 32), I_RG = 24 * 8;
    for (int it = gw; it < I_IN + 2 * I_SQ + I_PP + I_RG; it += NGW) {
        int r = it;
        if (r < I_IN) { tr_matrix_item(a.in[8], D, NIN, (bf16*)(ws + WS_WIN), 0, r, scr, lane); continue; } r -= I_IN;
        if (r < I_SQ) { tr_matrix_item(a.in[16], D, D, (bf16*)(ws + WS_WOUT), 0, r, scr, lane); continue; } r -= I_SQ;
        if (r < I_SQ) { tr_matrix_item(a.in[25], D, D, (bf16*)(ws + WS_WPG), 0, r, scr, lane); continue; } r -= I_SQ;
        if (r < I_PP) { tr_matrix_item(a.in[24], 256, D, (bf16*)(ws + WS_WPP), 0, r, scr, lane); continue; } r -= I_PP;
        { const int mi = r >> 3, sub = r & 7, gate = mi / 12, g = mi % 12, kb = sub >> 2, nb = sub & 3;
          const float* W = (gate ? a.in[13] : a.in[11]) + (size_t)g * 128 * 128; bf16* WT = (bf16*)(ws + WS_WRG);
          const int drow0 = 256 * g + 128 * gate + 32 * nb;
          tr_item(W, 128, 64 * kb, 32 * nb, WT, drow0, 256, 128 * (g & 1) + 64 * kb, scr, lane);
          const int c = lane & 7;
#pragma unroll
          for (int j = 0; j < 4; ++j) { const int n = (lane >> 3) + 8 * j; *(v4u*)(WT + (size_t)(drow0 + n) * 256 + 128 * ((g & 1) ^ 1) + 64 * kb + 8 * c) = (v4u){0u, 0u, 0u, 0u}; } }
    }
}
__device__ __forceinline__ void cvt_rows(const float* src, bf16* dst, size_t n, int gtid, int gthreads) {
    for (size_t i = (size_t)gtid * 8; i < n; i += (size_t)gthreads * 32) {
        f32x4 a[4], b[4];
#pragma unroll
        for (int k = 0; k < 4; ++k) if (i + (size_t)k * gthreads * 8 < n) { a[k] = __builtin_nontemporal_load((const f32x4*)(src + i + (size_t)k * gthreads * 8)); b[k] = __builtin_nontemporal_load((const f32x4*)(src + i + (size_t)k * gthreads * 8 + 4)); }
#pragma unroll
        for (int k = 0; k < 4; ++k) if (i + (size_t)k * gthreads * 8 < n) *(v4u*)(dst + i + (size_t)k * gthreads * 8) = (v4u){pk2(a[k][0], a[k][1]), pk2(a[k][2], a[k][3]), pk2(b[k][0], b[k][1]), pk2(b[k][2], b[k][3])};
    }
}
__device__ __forceinline__ void ln_rows(float* z, bf16* xb, const float* g, const float* b, int gw, int NGW, int lane) {
    for (int m = gw; m < M; m += NGW) {
        f32x4* zr = (f32x4*)(z + (size_t)m * D) + lane; f32x4 v[8]; float s = 0.f;
#pragma unroll
        for (int j = 0; j < 8; ++j) { v[j] = zr[64 * j]; s += (v[j][0] + v[j][1]) + (v[j][2] + v[j][3]); }
        const float mean = wave_sum(s) * (1.f / D); float s2 = 0.f;
#pragma unroll
        for (int j = 0; j < 8; ++j) { v[j] = v[j] - mean; s2 += (v[j][0] * v[j][0] + v[j][1] * v[j][1]) + (v[j][2] * v[j][2] + v[j][3] * v[j][3]); }
        const float rstd = 1.f / sqrtf(wave_sum(s2) * (1.f / D) + LN_EPS);
        v2u* o8 = (v2u*)(xb + (size_t)m * D) + lane;
#pragma unroll
        for (int j = 0; j < 8; ++j) { const f32x4 gg = *((const f32x4*)g + lane + 64 * j), bb = *((const f32x4*)b + lane + 64 * j);
            const f32x4 y = v[j] * rstd * gg + bb; zr[64 * j] = y; o8[64 * j] = (v2u){pk2(y[0], y[1]), pk2(y[2], y[3])}; }
    }
}
__device__ __forceinline__ void conv_rows(const bf16* proj, const float* cw, const float* cb, bf16* xc, int gtid, int gthreads) {
    for (int it = gtid; it < (M / 4) * (LW / 8); it += gthreads) {
        const int m0 = (it / (LW / 8)) * 4, c8 = (it % (LW / 8)) * 8, t0 = m0 & (SEQ - 1);
        v4u xv[7];
#pragma unroll
        for (int j = 0; j < 7; ++j) xv[j] = (t0 - 3 + j >= 0) ? *(const v4u*)(proj + SEC_XB + (size_t)(m0 - 3 + j) * LW + c8) : (v4u){0u, 0u, 0u, 0u};
        f32x4 w[4][2];
#pragma unroll
        for (int j = 0; j < 4; ++j) { w[j][0] = *(const f32x4*)(cw + j * LW + c8); w[j][1] = *(const f32x4*)(cw + j * LW + c8 + 4); }
        const f32x4 b0 = *(const f32x4*)(cb + c8), b1 = *(const f32x4*)(cb + c8 + 4);
#pragma unroll
        for (int r = 0; r < 4; ++r) { float acc[8] = {b0[0], b0[1], b0[2], b0[3], b1[0], b1[1], b1[2], b1[3]};
#pragma unroll
            for (int j = 0; j < 4; ++j) { const v4u x = xv[r + j];
                acc[0] += w[j][0][0] * bflo(x[0]); acc[1] += w[j][0][1] * bfhi(x[0]); acc[2] += w[j][0][2] * bflo(x[1]); acc[3] += w[j][0][3] * bfhi(x[1]);
                acc[4] += w[j][1][0] * bflo(x[2]); acc[5] += w[j][1][1] * bfhi(x[2]); acc[6] += w[j][1][2] * bflo(x[3]); acc[7] += w[j][1][3] * bfhi(x[3]); }
            *(v4u*)(xc + (size_t)(m0 + r) * LW + c8) = (v4u){pk2(acc[0], acc[1]), pk2(acc[2], acc[3]), pk2(acc[4], acc[5]), pk2(acc[6], acc[7])}; }
    }
}
typedef short s16x8 __attribute__((ext_vector_type(8)));
typedef short s16x4 __attribute__((ext_vector_type(4)));
typedef float f32x16 __attribute__((ext_vector_type(16)));
typedef float f32x2_t __attribute__((ext_vector_type(2))); typedef __bf16 bf16x2_t __attribute__((ext_vector_type(2)));
__device__ __forceinline__ unsigned cvtpk(float lo, float hi) { f32x2_t v = {lo, hi}; bf16x2_t b = __builtin_convertvector(v, bf16x2_t); return __builtin_bit_cast(unsigned, b); }
__device__ __forceinline__ s16x4 vtr(LAS unsigned char* p) { return __builtin_bit_cast(s16x4, __builtin_amdgcn_ds_read_tr16_b64_v4i16((LAS s16x4*)p)); }
__device__ __forceinline__ int crow(int r, int h) { return (r & 3) + 8 * (r >> 2) + 4 * h; }
__device__ __forceinline__ void attn_mfma(bf16* hb, float* lse, LAS unsigned char* lds, int gw, int NGW, int wave, int lane) {
    LAS unsigned char* kbuf = lds + wave * 16896;
    LAS unsigned char* vbuf = kbuf + 8704;
    const int q32 = lane & 31, hh = lane >> 5;
    const int trl = (4 * hh + ((lane & 15) >> 2)) * 64 + ((lane >> 4) & 1) * 32 + (lane & 3) * 8;
    const int ckey = lane >> 4, cdc = lane & 15;
    const int kst = ckey * 272 + cdc * 16, vst = ((cdc >> 2) * 4) * 512 + ckey * 64 + (cdc & 3) * 16;
    const float C = 0.08838834764831845f * 1.4426950408889634f;
    bf16* Kg = hb + SEC_K; bf16* Vg = hb + SEC_V;
    const int G_ = NGW / NWAVES, bid_ = gw / NWAVES, xcd = bid_ & 7, nw = (G_ >> 3) * NWAVES, lw = (bid_ >> 3) * NWAVES + wave;
    for (int u = lw; u < 768 && (bid_ >> 3) < (G_ >> 3); u += nw) {
        const int qg = u & 3, rn = (u >> 2) & 63, g = u >> 8, b = xcd >> 2, hkv = xcd & 3, hq = g * 4 + hkv;
        const int dsh = 2 * g, nbsh = 6 - dsh;
        const int r = rn >> nbsh, n = rn & ((1 << nbsh) - 1);
        const size_t mq = (size_t)b * SEQ + (size_t)(((128 * n + 32 * qg + q32) << dsh) + r);
        bf16* qp = hb + mq * 1536 + hq * 128;
        const int iq = 32 * qg + q32;
        const int kt1 = qg + 4, kt0 = (n == 0) ? 4 : qg;
        v4u kr[8], vr[8];
#define ATT_LOAD(kt) do { const int km0_ = 128 * (n - 1) + 32 * (kt); _Pragma("unroll") for (int i = 0; i < 8; ++i) { \
            const size_t off_ = ((size_t)b * SEQ + (size_t)(((km0_ + ckey + 4 * i) << dsh) + r)) * 512 + hkv * 128 + 8 * cdc; kr[i] = *(const v4u*)(Kg + off_); vr[i] = *(const v4u*)(Vg + off_); } } while (0)
#define ATT_STORE() do { _Pragma("unroll") for (int i = 0; i < 8; ++i) { *(LAS v4u*)(kbuf + kst + i * 1088) = kr[i]; *(LAS v4u*)(vbuf + vst + (i >> 1) * 512 + (i & 1) * 256) = vr[i]; } } while (0)
        unsigned klist = 0; int ntile = 0;
        { const int base5 = (4 * n + qg + 1) % 5;
#pragma unroll
          for (int sg = 0; sg < 5; ++sg) { const int kt = qg + (sg - base5 + 5) % 5; if (kt >= kt0) { klist |= (unsigned)kt << (4 * ntile); ++ntile; } } }
        ATT_LOAD((int)(klist & 15u));
        s16x8 qf[8];
#pragma unroll
        for (int ks = 0; ks < 8; ++ks) qf[ks] = *(const s16x8*)(qp + 16 * ks + 8 * hh);
        f32x16 O[4];
#pragma unroll
        for (int dt = 0; dt < 4; ++dt)
#pragma unroll
            for (int e = 0; e < 16; ++e) O[dt][e] = 0.f;
        float mrun = -INFINITY, lrun = 0.f;
        ATT_STORE();
        for (int ti = 0; ti < ntile; ++ti) {
            const int kt = (int)((klist >> (4 * ti)) & 15u);
            asm volatile("" ::: "memory");
            if (ti + 1 < ntile) ATT_LOAD((int)((klist >> (4 * ti + 4)) & 15u));
            f32x16 S;
#pragma unroll
            for (int e = 0; e < 16; ++e) S[e] = 0.f;
#pragma unroll
            for (int ks = 0; ks < 8; ++ks) { const s16x8 kf = *(const LAS s16x8*)(kbuf + q32 * 272 + 32 * ks + 16 * hh); S = __builtin_amdgcn_mfma_f32_32x32x16_bf16(kf, qf[ks], S, 0, 0, 0); }
            float t[16]; float mt = -INFINITY;
#pragma unroll
            for (int e = 0; e < 16; ++e) t[e] = S[e] * C;
            if (kt == qg || kt == kt1) {
#pragma unroll
                for (int e = 0; e < 16; ++e) { const int j = 32 * kt + crow(e, hh);
                    if (kt == qg ? (j < iq) : (j > iq + 128)) t[e] = -INFINITY; } }
#pragma unroll
            for (int e = 0; e < 16; ++e) mt = fmaxf(mt, t[e]);
            mt = fmaxf(mt, __shfl_xor(mt, 32));
            const float mnew = fmaxf(mrun, mt), alpha = __builtin_amdgcn_exp2f(mrun - mnew);
            float ps = 0.f;
#pragma unroll
            for (int e = 0; e < 16; ++e) { t[e] = __builtin_amdgcn_exp2f(t[e] - mnew); ps += t[e]; }
            lrun = lrun * alpha + ps; mrun = mnew;
            if (ti > 0 && __builtin_amdgcn_ballot_w64(alpha != 1.0f) != 0ull) {
#pragma unroll
                for (int dt = 0; dt < 4; ++dt) O[dt] = O[dt] * alpha; }
            s16x8 pb[2];
#pragma unroll
            for (int s = 0; s < 2; ++s) { v4u w; w[0] = cvtpk(t[8 * s], t[8 * s + 1]); w[1] = cvtpk(t[8 * s + 2], t[8 * s + 3]); w[2] = cvtpk(t[8 * s + 4], t[8 * s + 5]); w[3] = cvtpk(t[8 * s + 6], t[8 * s + 7]); pb[s] = __builtin_bit_cast(s16x8, w); }
#pragma unroll
            for (int dt = 0; dt < 4; ++dt)
#pragma unroll
                for (int s = 0; s < 2; ++s) { const s16x4 lo = vtr(vbuf + (dt * 4 + 2 * s) * 512 + trl), hi = vtr(vbuf + (dt * 4 + 2 * s + 1) * 512 + trl);
                    const s16x8 vf = {lo[0], lo[1], lo[2], lo[3], hi[0], hi[1], hi[2], hi[3]};
                    O[dt] = __builtin_amdgcn_mfma_f32_32x32x16_bf16(vf, pb[s], O[dt], 0, 0, 0); }
            asm volatile("" ::: "memory");
            if (ti + 1 < ntile) ATT_STORE();
        }
#undef ATT_LOAD
#undef ATT_STORE
        const float ltot = lrun + __shfl_xor(lrun, 32), inv = 1.0f / ltot;
#pragma unroll
        for (int dt = 0; dt < 4; ++dt)
#pragma unroll
            for (int rg = 0; rg < 4; ++rg) { const int d0 = 32 * dt + 8 * rg + 4 * hh;
                *(v2u*)(qp + d0) = (v2u){cvtpk(O[dt][4 * rg] * inv, O[dt][4 * rg + 1] * inv), cvtpk(O[dt][4 * rg + 2] * inv, O[dt][4 * rg + 3] * inv)}; }
        if (hh == 0) lse[mq * 12 + hq] = (mrun + __builtin_amdgcn_logf(ltot)) * 0.6931471805599453f;
    }
}
__device__ __forceinline__ void merge_rows(const bf16* proj, const float* lse, bf16* cat, int gtid, int gthreads) {
    for (int it0 = gtid; it0 < M * 64; it0 += 4 * gthreads) {
        v4u o[4][3]; float l[4][3];
#pragma unroll
        for (int k = 0; k < 4; ++k) { const int it = min(it0 + k * gthreads, M * 64 - 1), m = it >> 6, h = (it >> 4) & 3, c8 = (it & 15) * 8;
            const bf16* qp = proj + (size_t)m * 1536 + h * 128 + c8;
#pragma unroll
            for (int g = 0; g < 3; ++g) { l[k][g] = __builtin_nontemporal_load(lse + (size_t)m * 12 + 4 * g + h); o[k][g] = __builtin_nontemporal_load((const v4u*)(qp + 512 * g)); } }
#pragma unroll
        for (int k = 0; k < 4; ++k) { const int it = it0 + k * gthreads, m = it >> 6, h = (it >> 4) & 3, c8 = (it & 15) * 8; if (it >= M * 64) break;
            const float mx = fmaxf(fmaxf(l[k][0], l[k][1]), l[k][2]); float w0 = __expf(l[k][0] - mx), w1 = __expf(l[k][1] - mx), w2 = __expf(l[k][2] - mx);
            const float inv = 1.0f / (w0 + w1 + w2); w0 *= inv; w1 *= inv; w2 *= inv;
            v4u r;
#pragma unroll
            for (int e = 0; e < 4; ++e) r[e] = cvtpk(w0 * bflo(o[k][0][e]) + w1 * bflo(o[k][1][e]) + w2 * bflo(o[k][2][e]), w0 * bfhi(o[k][0][e]) + w1 * bfhi(o[k][1][e]) + w2 * bfhi(o[k][2][e]));
            *(v4u*)(cat + (((size_t)((m >> 13) * 128 + h * 8 + (c8 >> 4)) * SEQ + (m & (SEQ - 1))) * 16 + (c8 & 15))) = r; }
    }
}
__device__ __forceinline__ void scan_items(const bf16* ca, const bf16* uu, const bf16* yg, bf16* cat, LAS float* sm, int G, int bid, int tid, unsigned long long* tsp) {
    const int half = tid & 1, sl = tid >> 1, ce = half * 8;
    LAS float* sP = sm; LAS float* sH = sm + 4096; LAS float* gP = sm + 8192; LAS float* gH = sm + 8192 + 512;
    const int slot = bid >> 3, nslot = G >> 3;
    for (int it_ = slot; it_ < 24; it_ += nslot) {
        const int item = (bid & 7) * 24 + it_;
        const int b = item / (LW / 16), cb = item % (LW / 16);
        const size_t o0 = ((size_t)item * SEQ + sl * 32) * 16 + ce;
        const bf16* cp = ca + o0; const bf16* up = uu + o0; const bf16* yp = yg + o0;
        float P[8], H[8];
#pragma unroll
        for (int e = 0; e < 8; ++e) { P[e] = 1.f; H[e] = 0.f; }
#pragma unroll 8
        for (int t = 0; t < 32; ++t) { const v4u cv = *(const v4u*)(cp + t * 16), uv = *(const v4u*)(up + t * 16);
#pragma unroll
            for (int e = 0; e < 4; ++e) { const float a0 = 1.0f - bflo(cv[e]), a1 = 1.0f - bfhi(cv[e]); H[2 * e] = a0 * H[2 * e] + bflo(uv[e]); H[2 * e + 1] = a1 * H[2 * e + 1] + bfhi(uv[e]); P[2 * e] *= a0; P[2 * e + 1] *= a1; } }
#pragma unroll
        for (int e = 0; e < 8; ++e) { sP[sl * 16 + ce + e] = P[e]; sH[sl * 16 + ce + e] = H[e]; }
        __syncthreads();
        { const int ch = tid & 15, grp = tid >> 4; float p = 1.f, h = 0.f;
#pragma unroll
          for (int k = 0; k < 8; ++k) { const float pp = sP[(grp * 8 + k) * 16 + ch]; h = pp * h + sH[(grp * 8 + k) * 16 + ch]; p *= pp; }
          gP[grp * 16 + ch] = p; gH[grp * 16 + ch] = h; }
        __syncthreads();
        float h[8];
#pragma unroll
        for (int e = 0; e < 8; ++e) h[e] = 0.f;
        const int grp = sl >> 3;
        for (int gg = 0; gg < grp; ++gg)
#pragma unroll
            for (int e = 0; e < 8; ++e) h[e] = gP[gg * 16 + ce + e] * h[e] + gH[gg * 16 + ce + e];
        for (int s2 = grp * 8; s2 < sl; ++s2)
#pragma unroll
            for (int e = 0; e < 8; ++e) h[e] = sP[s2 * 16 + ce + e] * h[e] + sH[s2 * 16 + ce + e];
        const size_t m0 = (size_t)b * SEQ + sl * 32;
        if (tsp && bid == 0 && tid == 0) tsp[24] = __builtin_amdgcn_s_memrealtime();
#pragma unroll 8
        for (int t = 0; t < 32; ++t) { const v4u cv = *(const v4u*)(cp + t * 16), uv = *(const v4u*)(up + t * 16), yv = __builtin_nontemporal_load((const v4u*)(yp + t * 16));
            v4u o;
#pragma unroll
            for (int e = 0; e < 4; ++e) { h[2 * e] = (1.0f - bflo(cv[e])) * h[2 * e] + bflo(uv[e]); h[2 * e + 1] = (1.0f - bfhi(cv[e])) * h[2 * e + 1] + bfhi(uv[e]);
                o[e] = cvtpk(h[2 * e] * bflo(yv[e]), h[2 * e + 1] * bfhi(yv[e])); }
            *(v4u*)(cat + (((size_t)(b * 128 + 32 + cb) * SEQ + sl * 32 + t) * 16 + ce)) = o; }
        __syncthreads();
    }
}

__device__ __forceinline__ void grid_bar(unsigned* cnt, unsigned target) {
    asm volatile("s_waitcnt vmcnt(0)" ::: "memory");
    __syncthreads();
    if (threadIdx.x == 0) {
        __builtin_amdgcn_fence(__ATOMIC_RELEASE, "agent");
        __hip_atomic_fetch_add(cnt, 1u, __ATOMIC_RELAXED, __HIP_MEMORY_SCOPE_AGENT);
        unsigned spins = 0;
        while (__hip_atomic_load(cnt, __ATOMIC_RELAXED, __HIP_MEMORY_SCOPE_AGENT) < target && ++spins < (1u << 24)) __builtin_amdgcn_s_sleep(1);
        __builtin_amdgcn_fence(__ATOMIC_ACQUIRE, "agent");
        asm volatile("s_waitcnt vmcnt(0)" ::: "memory");
    }
    __syncthreads();
}
#ifndef MK_N_LAUNCHES
#define MK_N_LAUNCHES 1
#endif
constexpr int NPHASES = 14;
constexpr int W2_EARLY = 10240;
__global__ void __launch_bounds__(NTHREADS, 2) fwd_kernel(Args a) {
    extern __shared__ __attribute__((aligned(16))) unsigned char lds_raw[];
    LAS unsigned char* lds = (LAS unsigned char*)lds_raw;
    const int G = gridDim.x, bid = blockIdx.x, NGW = G * NWAVES, gthreads = G * NTHREADS;
#define PHASE_VARS int tid = threadIdx.x; asm volatile("" : "+v"(tid)); const int lane = tid & 63, wave = __builtin_amdgcn_readfirstlane(tid >> 6), gw = bid * NWAVES + wave, gtid = bid * NTHREADS + tid; \
    LAS float* scr = (LAS float*)(lds + wave * 16384); (void)lane; (void)gw; (void)gtid; (void)scr;
    unsigned char* ws = a.ws;
    bf16* XB = (bf16*)(ws + WS_XB); bf16* HB = (bf16*)(ws + WS_H); float* PP = (float*)(ws + WS_H);
    bf16* XC = (bf16*)(ws + WS_XC); bf16* LA = (bf16*)(ws + WS_LA); bf16* UU = (bf16*)(ws + WS_U); float* LSE = (float*)(ws + WS_LSE);
    const float* x = a.in[0]; float* out = a.out;
    const int lo = a.ph_lo, hi = a.ph_hi;
#ifndef PHASE_MASK
#define PHASE_MASK 0xffff
#endif
#define IN(k) (((PHASE_MASK >> (k)) & 1) && lo <= (k) && (k) < hi)
#ifdef PROBE_K
#define SCAN_TSP ((unsigned long long*)(ws + WS_TS))
#define STAMP(k) do { if (bid == 0 && threadIdx.x == 0) ((unsigned long long*)(ws + WS_TS))[(k) + 1] = __builtin_amdgcn_s_memrealtime(); } while (0)
#else
#define SCAN_TSP ((unsigned long long*)nullptr)
#define STAMP(k) do { } while (0)
#endif
#define SEAM(k) do { if (hi > (k) + 1) { if ((k) == 0 || MK_N_LAUNCHES != 1) cg::this_grid().sync(); else grid_bar((unsigned*)(ws + WS_BAR), (++nbar) * (unsigned)G); } STAMP(k); } while (0)
    typedef pg8::StaticOrder SO;
    unsigned nbar = 0;
    if (bid == 0) for (int i = threadIdx.x; i < 3 * 64 * 64; i += NTHREADS) ((unsigned*)(ws + WS_CNT))[i] = 0u;
    if (bid == 0 && threadIdx.x == 0) __hip_atomic_store((unsigned*)(ws + WS_BAR), 0u, __ATOMIC_RELAXED, __HIP_MEMORY_SCOPE_AGENT);
    STAMP(-1);
    if (IN(0)) {
        PHASE_VARS
        convert_ffn(a.in[3], a.in[4], a.in[5], ws, scr, 0, 3 * IT_FF, gw, NGW, lane);
        convert_rest(a, scr, gw, NGW, lane);
        cvt_rows(x, XB, (size_t)M * D, gtid, gthreads);
        cvt_rows(a.in[1], (bf16*)(ws + WS_PB), (size_t)M * 256, gtid, gthreads);
        if (gtid < LW) ((float*)(ws + WS_SP))[gtid] = -8.0f * log1pf(expf(-a.in[15][gtid]));
        __syncthreads(); SEAM(0);
    }
    if (IN(1)) {
        PHASE_VARS
        pg8::Gemm g{XB, (const bf16*)(ws + WS_WFGU), M, 2 * FF, D, D, 0, 0}; SO S; S.init(M, 2 * FF, G, bid);
        pg8::EpiSwiglu E{HB, FF};
        pg8::gemm_phase<pg8::EpiSwiglu, SO, true, true>(lds, g, S, E);
        SEAM(1);
    }
    if (IN(2)) {
        PHASE_VARS
        pg8::Gemm g{HB, (const bf16*)(ws + WS_WFD), M, D, FF, FF, 0, 2}; SO S; S.init(M, D, G, bid);
        pg8::EpiResLn<false> E{x, nullptr, out, XB, D, ALPHA, 0.5f, a.in[6], a.in[7], (unsigned long long*)(ws + WS_SLOT), (unsigned*)(ws + WS_CNT), lds + 131072};
        pg8::gemm_phase<pg8::EpiResLn<false>, SO, false, true>(lds, g, S, E);
        SEAM(2);
    }
    if (IN(4)) {
        PHASE_VARS
        pg8::Gemm g{XB, (const bf16*)(ws + WS_WIN), M, NIN, D, D, 0, 0}; SO S; S.init(M, NIN, G, bid);
        pg8::EpiInProj E{HB, (const int*)a.in[2]};
        pg8::gemm_phase<pg8::EpiInProj, SO, true, true>(lds, g, S, E);
        if (5 * G + bid >= (M / 256) * (NIN / 256)) { __syncthreads(); const int first = (M / 256) * (NIN / 256) - 5 * G; convert_ffn(a.in[19], a.in[20], a.in[21], ws, scr, 0, W2_EARLY, (bid - first) * NWAVES + wave, (G - first) * NWAVES, lane); __syncthreads(); }
        SEAM(4);
    }
    if (IN(5)) {
        PHASE_VARS
        conv_rows(HB, a.in[9], a.in[10], XC, gtid, gthreads);
        convert_ffn(a.in[19], a.in[20], a.in[21], ws, scr, W2_EARLY, 3 * IT_FF, gw, NGW, lane);
        __syncthreads();
        SEAM(5);
    }
    if (IN(6)) {
        PHASE_VARS
        pg8::Gemm g{XC, (const bf16*)(ws + WS_WRG), M, 3072, 256, LW, 256, 0}; SO S; S.init(M, 3072, G, bid);
        pg8::EpiLru E{XC, LA, UU, a.in[12], a.in[14], (const float*)(ws + WS_SP)};
        pg8::gemm_phase<pg8::EpiLru, SO, true, true>(lds, g, S, E);
        __syncthreads(); STAMP(19);
        attn_mfma(HB, LSE, lds, gw, NGW, wave, lane); __syncthreads(); STAMP(21);
        SEAM(6);
    }
    if (IN(7)) {
        PHASE_VARS
        __syncthreads();
        scan_items(LA, UU, HB + SEC_YG, HB + SEC_K, (LAS float*)lds, G, bid, tid, SCAN_TSP);
        merge_rows(HB, LSE, HB + SEC_K, gtid, gthreads);
        SEAM(7);
    }
    if (IN(8)) {
        PHASE_VARS
        pg8::Gemm g{HB + SEC_K, (const bf16*)(ws + WS_WOUT), M, D, D, D, 0, 1}; SO S; S.init(M, D, G, bid);
        pg8::EpiResLn<true> E{nullptr, XB, out, XB, D, ALPHA, 1.0f, a.in[17], a.in[18], (unsigned long long*)(ws + WS_SLOT + 524288), (unsigned*)(ws + WS_CNT) + 4096, lds + 131072};
        pg8::gemm_phase<pg8::EpiResLn<true>, SO, false, true>(lds, g, S, E);
        SEAM(8);
    }
    if (IN(10)) {
        PHASE_VARS
        pg8::Gemm g{XB, (const bf16*)(ws + WS_WFGU), M, 2 * FF, D, D, 0, 0}; SO S; S.init(M, 2 * FF, G, bid);
        pg8::EpiSwiglu E{HB, FF};
        pg8::gemm_phase<pg8::EpiSwiglu, SO, true, true>(lds, g, S, E);
        SEAM(10);
    }
    if (IN(11)) {
        PHASE_VARS
        pg8::Gemm g{HB, (const bf16*)(ws + WS_WFD), M, D, FF, FF, 0, 2}; SO S; S.init(M, D, G, bid);
        pg8::EpiResLn<true> E{nullptr, XB, out, XB, D, ALPHA, 0.5f, a.in[22], a.in[23], (unsigned long long*)(ws + WS_SLOT + 2 * 524288), (unsigned*)(ws + WS_CNT) + 2 * 4096, lds + 131072};
        pg8::gemm_phase<pg8::EpiResLn<true>, SO, false, true>(lds, g, S, E);
        SEAM(11);
    }
    if (IN(13)) {
        PHASE_VARS
        { pg8::Gemm g{(const bf16*)(ws + WS_PB), (const bf16*)(ws + WS_WPP), M, D, 256, 256, 0, 0}; SO S; S.init(M, D, G, bid);
          pg8::EpiBf16 E{HB, D};
          pg8::gemm_phase<pg8::EpiBf16, SO, true, true>(lds, g, S, E); __syncthreads(); __builtin_amdgcn_fence(__ATOMIC_ACQUIRE, "agent"); __syncthreads(); }
        pg8::Gemm g{XB, (const bf16*)(ws + WS_WPG), M, D, D, D, 0, 0}; SO S; S.init(M, D, G, bid);
        pg8::EpiPle E{XB, out, HB, D};
        pg8::gemm_phase<pg8::EpiPle, SO, true, true>(lds, g, S, E);
    }
#ifdef PROBE_K
    cg::this_grid().sync();
    if (bid == 0) { const unsigned long long* ts = (const unsigned long long*)(ws + WS_TS); const int n = (int)((ts[PROBE_K + 1] - ts[PROBE_K0]) / 100ull);
        for (int i = threadIdx.x; i < n; i += NTHREADS) out[(size_t)i * 4099 + 7] += 0.0625f; }
#endif
#undef IN
#undef SEAM
}

extern "C" void kernel_launch(void* const* d_in, const int* in_sizes, int n_in, void* d_out, int out_size, void* d_ws, size_t ws_size, hipStream_t stream) {
    static int grid = 0;
    if (grid == 0) {
        if (n_in != 26 || out_size != M * D || ws_size < WS_END) { fprintf(stderr, "kernel_launch: unexpected problem (n_in %d, out %d, ws %zu)\n", n_in, out_size, ws_size); grid = -1; return; }
        int dev = 0, cus = 0, per_cu = 0;
        (void)hipGetDevice(&dev); (void)hipDeviceGetAttribute(&cus, hipDeviceAttributeMultiprocessorCount, dev);
        if (hipFuncSetAttribute((const void*)fwd_kernel, hipFuncAttributeMaxDynamicSharedMemorySize, LDS_BYTES) != hipSuccess) { fprintf(stderr, "kernel_launch: hipFuncSetAttribute failed\n"); grid = -1; return; }
        if (hipOccupancyMaxActiveBlocksPerMultiprocessor(&per_cu, (const void*)fwd_kernel, NTHREADS, LDS_BYTES) != hipSuccess || per_cu < 1) { fprintf(stderr, "kernel_launch: occupancy query says %d\n", per_cu); per_cu = 1; }
        (void)hipGetLastError();
        grid = cus * 1;
        if (grid != 256) { fprintf(stderr, "kernel_launch: built for a 256-CU device (fused LayerNorm epilogues need 256 workgroups), got %d\n", grid); grid = -1; return; }
    }
    if (grid < 0) return;
    Args a{};
    for (int i = 0; i < 26; ++i) a.in[i] = (const float*)d_in[i];
    a.out = (float*)d_out; a.ws = (unsigned char*)d_ws;
#if MK_N_LAUNCHES == 1
    a.ph_lo = 0; a.ph_hi = NPHASES;
    void* args[] = {&a};
    hipError_t e = hipLaunchCooperativeKernel((const void*)fwd_kernel, dim3(grid), dim3(NTHREADS), args, LDS_BYTES, stream);
    if (e != hipSuccess) fprintf(stderr, "cooperative launch failed: %s (grid %d)\n", hipGetErrorString(e), grid);
#else
    for (int p = 0; p < NPHASES; ++p) { a.ph_lo = p; a.ph_hi = p + 1; hipLaunchKernelGGL(fwd_kernel, dim3(grid), dim3(NTHREADS), LDS_BYTES, stream, a); }
#endif
}
```

```cpp
#include <hip/hip_runtime.h>
#include <hip/hip_cooperative_groups.h>
#include <cstdio>
#include <cstdint>
#include <type_traits>
namespace cg = cooperative_groups;
namespace pg8 {
#define PG8_LAS __attribute__((address_space(3)))
typedef unsigned short bf16_t;
typedef short bf16x8 __attribute__((ext_vector_type(8)));
typedef float f32x4 __attribute__((ext_vector_type(4)));
typedef unsigned u32x4 __attribute__((ext_vector_type(4)));
constexpr int BM = 256, BK = 64, HALF = 128, HTB = HALF * BK * 2  , STAGE_BYTES = 8 * HTB, NXCD = 8, WGM = 8;

__host__ __device__ __forceinline__ int lds_byte(int r, int c) { const int st = (r >> 4) * 2 + (c >> 5), rr = r & 15, cc = c & 31, ob = rr * 64 + cc * 2; return st * 1024 + (ob ^ (((ob >> 9) & 1) << 5)); }
__host__ __device__ __forceinline__ void stage_rc(int b, int& R, int& C) { const int st = b / 1024, sb = b % 1024, swz = sb ^ (((sb >> 9) & 1) << 5); R = (st >> 1) * 16 + swz / 64; C = (st & 1) * 32 + (swz % 64) / 2; }
__host__ __device__ __forceinline__ int perm32(int rho) { const int n = rho >> 4, i = rho & 15; return 8 * (i >> 2) + 4 * n + (i & 3); }

struct Unit { int pm, pn; };
struct Gemm { const bf16_t* A; const bf16_t* Bt; int M, N, K, lda, apn2, ablk; };

struct StaticOrder {
    int nM, nN, nwg, G, c;
    __host__ __device__ void init(int M, int N, int G_, int c_) { nM = M / BM; nN = N / BM; nwg = nM * nN; G = G_; c = c_; }
    __host__ __device__ bool next(int i, Unit& u) const {
        const long L = (long)i * G + c; if (L >= nwg) return false;
        int wgid = (int)L; { const int q = nwg / NXCD, r = nwg % NXCD, xcd = wgid % NXCD, off = wgid / NXCD; wgid = (xcd < r ? xcd * (q + 1) : r * (q + 1) + (xcd - r) * q) + off; }
        const int nig = WGM * nN, gid = wgid / nig, fm = gid * WGM, gsz = (nM - fm) < WGM ? (nM - fm) : WGM;
        u.pm = fm + ((wgid % nig) % gsz); u.pn = (wgid % nig) / gsz; return true;
    }
    __device__ __forceinline__ void a_ready(const Unit&) const {}
    __device__ __forceinline__ void done(const Unit&) const {}
};

__device__ __forceinline__ unsigned cvt_pk_bf16(float lo, float hi) { unsigned r; asm volatile("v_cvt_pk_bf16_f32 %0, %1, %2" : "=v"(r) : "v"(lo), "v"(hi)); return r; }
typedef float f32x2 __attribute__((ext_vector_type(2)));

__device__ __forceinline__ float sigmoid_f(float v) { return __builtin_amdgcn_rcpf(1.0f + __builtin_amdgcn_exp2f(-1.4426950408889634f * v)); }
struct EpiBf16 {
    static constexpr bool PERM = true, AFTER_DRAIN = false;
    bf16_t* O; int ldc;
    __device__ __forceinline__ void operator()(const f32x4 (&acc)[2][2][4][2], const Unit& u, int wr, int wc, int fr, int fq) const {
        const int row0 = u.pm * BM + wr * 64 + fr, col0 = u.pn * BM + wc * 32 + 8 * fq;
#pragma unroll
        for (int ai = 0; ai < 2; ++ai)
#pragma unroll
            for (int m = 0; m < 4; ++m) { bf16_t* rowp = O + (size_t)(row0 + ai * HALF + m * 16) * ldc + col0;
#pragma unroll
                for (int bj = 0; bj < 2; ++bj) { const f32x4 v0 = acc[ai][bj][m][0], v1 = acc[ai][bj][m][1];
                    u32x4 w; w.x = cvt_pk_bf16(v0[0], v0[1]); w.y = cvt_pk_bf16(v0[2], v0[3]); w.z = cvt_pk_bf16(v1[0], v1[1]); w.w = cvt_pk_bf16(v1[2], v1[3]);
                    *(u32x4*)(rowp + bj * HALF) = w; } }
    }
};
struct EpiSwiglu {
    static constexpr bool PERM = true, AFTER_DRAIN = false;
    bf16_t* O; int ldc;
    __device__ __forceinline__ void operator()(const f32x4 (&acc)[2][2][4][2], const Unit& u, int wr, int wc, int fr, int fq) const {
        const int row0 = u.pm * BM + wr * 64 + fr, col0 = u.pn * HALF + wc * 32 + 8 * fq;
#pragma unroll
        for (int ai = 0; ai < 2; ++ai)
#pragma unroll
            for (int m = 0; m < 4; ++m) { bf16_t* rowp = O + ((size_t)(col0 >> 6) * 16384 + (size_t)(row0 + ai * HALF + m * 16)) * 64 + (col0 & 63);
                float h[8];
#pragma unroll
                for (int n = 0; n < 2; ++n)
#pragma unroll
                    for (int j = 0; j < 4; ++j) { const float g = acc[ai][0][m][n][j], up = acc[ai][1][m][n][j]; h[4 * n + j] = g * sigmoid_f(g) * up; }
                u32x4 w; w.x = cvt_pk_bf16(h[0], h[1]); w.y = cvt_pk_bf16(h[2], h[3]); w.z = cvt_pk_bf16(h[4], h[5]); w.w = cvt_pk_bf16(h[6], h[7]);
                *(u32x4*)rowp = w; }
    }
};
struct EpiResF32 {
    static constexpr bool PERM = false, AFTER_DRAIN = false;
    const float* base; float* out; int ldc; float alpha, s;
    __device__ __forceinline__ void operator()(const f32x4 (&acc)[2][2][4][2], const Unit& u, int wr, int wc, int fr, int fq) const {
        const int row0 = u.pm * BM + wr * 64 + fr, col0 = u.pn * BM + wc * 32 + 4 * fq;
#pragma unroll
        for (int ai = 0; ai < 2; ++ai)
#pragma unroll
            for (int m = 0; m < 4; ++m) { const size_t off = (size_t)(row0 + ai * HALF + m * 16) * ldc + col0;
#pragma unroll
                for (int bj = 0; bj < 2; ++bj)
#pragma unroll
                    for (int n = 0; n < 2; ++n) { f32x4 v = acc[ai][bj][m][n] * s; if (base) v += *(const f32x4*)(base + off + bj * HALF + n * 16) * alpha; *(f32x4*)(out + off + bj * HALF + n * 16) = v; } }
    }
};
template <bool BB> struct EpiResLn {
    static constexpr bool PERM = false, AFTER_DRAIN = true;
    const float* base; const bf16_t* baseb; float* zs; bf16_t* xb; int ldc; float alpha, s; const float* g; const float* b;
    unsigned long long* slots; unsigned* cnt; PG8_LAS unsigned char* xl;
    typedef float f32x2v __attribute__((ext_vector_type(2))); typedef unsigned u32x2v __attribute__((ext_vector_type(2)));
    typedef typename std::conditional<BB, u32x2v, f32x4>::type bvec;
    __device__ __forceinline__ bvec ldb(size_t o) const { if constexpr (BB) return *(const u32x2v*)(baseb + o); else return *(const f32x4*)(base + o); }
    static __device__ __forceinline__ f32x4 cvb(const bvec& v) { if constexpr (BB) return (f32x4){__uint_as_float(v.x << 16), __uint_as_float(v.x & 0xffff0000u), __uint_as_float(v.y << 16), __uint_as_float(v.y & 0xffff0000u)}; else return v; }
    __device__ __forceinline__ void first(const f32x4 (&acc)[2][2][4][2], const Unit& u, int wr, int wc, int fr, int fq) const {
        PG8_LAS f32x2v* SAp = (PG8_LAS f32x2v*)xl;
        const int row0 = u.pm * BM + wr * 64 + fr, col0 = u.pn * BM + wc * 32 + 4 * fq;
#pragma unroll
        for (int ai = 0; ai < 2; ++ai) { bvec bv[4][4];
#pragma unroll
            for (int m = 0; m < 4; ++m)
#pragma unroll
                for (int q = 0; q < 4; ++q) bv[m][q] = ldb((size_t)(row0 + ai * HALF + m * 16) * ldc + col0 + (q >> 1) * HALF + (q & 1) * 16);
#pragma unroll
            for (int m = 0; m < 4; ++m) { const size_t off = (size_t)(row0 + ai * HALF + m * 16) * ldc + col0; float s1 = 0.f, s2 = 0.f;
#pragma unroll
                for (int q = 0; q < 4; ++q) { const f32x4 v = acc[ai][q >> 1][m][q & 1] * s + cvb(bv[m][q]) * alpha; *(f32x4*)(zs + off + (q >> 1) * HALF + (q & 1) * 16) = v;
                    s1 += (v[0] + v[1]) + (v[2] + v[3]); s2 += (v[0] * v[0] + v[1] * v[1]) + (v[2] * v[2] + v[3] * v[3]); }
                s1 += __shfl_xor(s1, 16); s1 += __shfl_xor(s1, 32); s2 += __shfl_xor(s2, 16); s2 += __shfl_xor(s2, 32);
                if (fq == 0) SAp[(ai * HALF + wr * 64 + m * 16 + fr) * 4 + wc] = (f32x2v){s1, s2}; }
            asm volatile("" ::: "memory"); }
    }
    __device__ __forceinline__ void fused(f32x4 (&acc)[2][2][4][2], const Unit& u, int wr, int wc, int fr, int fq, PG8_LAS unsigned char* lds, int wid, int lane) const {
        PG8_LAS f32x2v* P = (PG8_LAS f32x2v*)lds;
        PG8_LAS f32x2v* SAp = (PG8_LAS f32x2v*)xl;
        PG8_LAS f32x2v* St = (PG8_LAS f32x2v*)(lds + 8192);
        const int row0 = u.pm * BM + wr * 64 + fr, col0 = u.pn * BM + wc * 32 + 4 * fq;
#pragma unroll
        for (int ai = 0; ai < 2; ++ai) { bvec bv[4][4];
#pragma unroll
            for (int m = 0; m < 4; ++m)
#pragma unroll
                for (int q = 0; q < 4; ++q) bv[m][q] = ldb((size_t)(row0 + ai * HALF + m * 16) * ldc + col0 + (q >> 1) * HALF + (q & 1) * 16);
#pragma unroll
            for (int m = 0; m < 4; ++m) { float s1 = 0.f, s2 = 0.f;
#pragma unroll
                for (int q = 0; q < 4; ++q) { const f32x4 v = acc[ai][q >> 1][m][q & 1] * s + cvb(bv[m][q]) * alpha; acc[ai][q >> 1][m][q & 1] = v;
                    s1 += (v[0] + v[1]) + (v[2] + v[3]); s2 += (v[0] * v[0] + v[1] * v[1]) + (v[2] * v[2] + v[3] * v[3]); }
                s1 += __shfl_xor(s1, 16); s1 += __shfl_xor(s1, 32); s2 += __shfl_xor(s2, 16); s2 += __shfl_xor(s2, 32);
                if (fq == 0) P[(ai * HALF + wr * 64 + m * 16 + fr) * 4 + wc] = (f32x2v){s1, s2}; }
            asm volatile("" ::: "memory"); }
        asm volatile("s_waitcnt lgkmcnt(0)" ::: "memory"); __builtin_amdgcn_s_barrier(); asm volatile("" ::: "memory");
        const int row = wid * 32 + (lane & 31);
        if (lane < 32) { float su = 0.f, sq = 0.f;
#pragma unroll
            for (int k = 0; k < 4; ++k) { const f32x2v a = P[row * 4 + k], c = SAp[row * 4 + k]; su += a.x + c.x; sq += a.y + c.y; }
            __hip_atomic_store(slots + ((size_t)(u.pm * BM + row) * 4 + (u.pn & 3)), ((unsigned long long)__float_as_uint(sq) << 32) | __float_as_uint(su), __ATOMIC_RELAXED, __HIP_MEMORY_SCOPE_AGENT); }
        asm volatile("s_waitcnt vmcnt(0)" ::: "memory");
        if (lane == 0) __hip_atomic_fetch_add(cnt + 64 * u.pm, 1u, __ATOMIC_RELAXED, __HIP_MEMORY_SCOPE_AGENT);
        if (wid == 0) { unsigned spins = 0;
            while ((unsigned)__builtin_amdgcn_readfirstlane(__hip_atomic_load(cnt + 64 * u.pm, __ATOMIC_RELAXED, __HIP_MEMORY_SCOPE_AGENT)) < 32u && ++spins < (1u << 22)) __builtin_amdgcn_s_sleep(2);
            __builtin_amdgcn_fence(__ATOMIC_ACQUIRE, "agent"); }
        asm volatile("s_waitcnt vmcnt(0) lgkmcnt(0)" ::: "memory"); __builtin_amdgcn_s_barrier(); asm volatile("" ::: "memory");
        if (lane < 32) { float su = 0.f, sq = 0.f; const unsigned long long* sl = slots + (size_t)(u.pm * BM + row) * 4;
#pragma unroll
            for (int k = 0; k < 4; ++k) { const unsigned long long w = __hip_atomic_load(sl + k, __ATOMIC_RELAXED, __HIP_MEMORY_SCOPE_AGENT); su += __uint_as_float((unsigned)w); sq += __uint_as_float((unsigned)(w >> 32)); }
            const float mean = su * (1.0f / 2048.0f), var = fmaxf(sq * (1.0f / 2048.0f) - mean * mean, 0.f);
            St[row] = (f32x2v){mean, 1.0f / sqrtf(var + 1e-5f)}; }
        asm volatile("s_waitcnt lgkmcnt(0)" ::: "memory"); __builtin_amdgcn_s_barrier(); asm volatile("" ::: "memory");
        { f32x4 gg[4], bb[4];
#pragma unroll
          for (int q = 0; q < 4; ++q) { gg[q] = *(const f32x4*)(g + col0 + (q >> 1) * HALF + (q & 1) * 16); bb[q] = *(const f32x4*)(b + col0 + (q >> 1) * HALF + (q & 1) * 16); }
#pragma unroll
          for (int ai = 0; ai < 2; ++ai)
#pragma unroll
            for (int m = 0; m < 4; ++m) { const int r = ai * HALF + wr * 64 + m * 16 + fr; const f32x2v sr = St[r]; const size_t off = (size_t)(u.pm * BM + r) * ldc + col0;
#pragma unroll
                for (int q = 0; q < 4; ++q) { const size_t o2 = off + (q >> 1) * HALF + (q & 1) * 16; const f32x4 y = (acc[ai][q >> 1][m][q & 1] - sr.x) * sr.y * gg[q] + bb[q];
                    *(u32x2v*)(xb + o2) = (u32x2v){cvt_pk_bf16(y[0], y[1]), cvt_pk_bf16(y[2], y[3])}; } } }
        asm volatile("" ::: "memory");
        { const int colA = col0 - 1024; f32x4 gg[4], bb[4];
#pragma unroll
          for (int q = 0; q < 4; ++q) { gg[q] = *(const f32x4*)(g + colA + (q >> 1) * HALF + (q & 1) * 16); bb[q] = *(const f32x4*)(b + colA + (q >> 1) * HALF + (q & 1) * 16); }
#pragma unroll
          for (int ai = 0; ai < 2; ++ai) { f32x4 zv[4][4];
#pragma unroll
            for (int m = 0; m < 4; ++m)
#pragma unroll
                for (int q = 0; q < 4; ++q) zv[m][q] = *(const f32x4*)(zs + (size_t)(u.pm * BM + ai * HALF + wr * 64 + m * 16 + fr) * ldc + colA + (q >> 1) * HALF + (q & 1) * 16);
#pragma unroll
            for (int m = 0; m < 4; ++m) { const int r = ai * HALF + wr * 64 + m * 16 + fr; const f32x2v sr = St[r]; const size_t off = (size_t)(u.pm * BM + r) * ldc + colA;
#pragma unroll
                for (int q = 0; q < 4; ++q) { const size_t o2 = off + (q >> 1) * HALF + (q & 1) * 16; const f32x4 y = (zv[m][q] - sr.x) * sr.y * gg[q] + bb[q];
                    *(u32x2v*)(xb + o2) = (u32x2v){cvt_pk_bf16(y[0], y[1]), cvt_pk_bf16(y[2], y[3])}; } }
            asm volatile("" ::: "memory"); } }
    }
};
struct EpiPle {
    static constexpr bool PERM = false, AFTER_DRAIN = false;
    const bf16_t* x3; float* xo; const bf16_t* pp; int ldc;
    typedef unsigned u32x2p __attribute__((ext_vector_type(2)));
    __device__ __forceinline__ void operator()(const f32x4 (&acc)[2][2][4][2], const Unit& u, int wr, int wc, int fr, int fq) const {
        const int row0 = u.pm * BM + wr * 64 + fr, col0 = u.pn * BM + wc * 32 + 4 * fq;
#pragma unroll
        for (int ai = 0; ai < 2; ++ai)
#pragma unroll
            for (int mp = 0; mp < 2; ++mp) { u32x2p xv[2][4], pv[2][4];
#pragma unroll
                for (int mm = 0; mm < 2; ++mm)
#pragma unroll
                    for (int q = 0; q < 4; ++q) { const size_t o2 = (size_t)(row0 + ai * HALF + (2 * mp + mm) * 16) * ldc + col0 + (q >> 1) * HALF + (q & 1) * 16; xv[mm][q] = *(const u32x2p*)(x3 + o2); pv[mm][q] = *(const u32x2p*)(pp + o2); }
#pragma unroll
                for (int mm = 0; mm < 2; ++mm)
#pragma unroll
                    for (int q = 0; q < 4; ++q) { const int m = 2 * mp + mm; const size_t o2 = (size_t)(row0 + ai * HALF + m * 16) * ldc + col0 + (q >> 1) * HALF + (q & 1) * 16;
                        const f32x4 a = acc[ai][q >> 1][m][q & 1]; const u32x2p xw = xv[mm][q], pw = pv[mm][q];
                        const f32x4 p = {__uint_as_float(pw.x << 16), __uint_as_float(pw.x & 0xffff0000u), __uint_as_float(pw.y << 16), __uint_as_float(pw.y & 0xffff0000u)};
                        f32x4 r; r[0] = __uint_as_float(xw.x << 16) + sigmoid_f(a[0]) * p[0]; r[1] = __uint_as_float(xw.x & 0xffff0000u) + sigmoid_f(a[1]) * p[1];
                        r[2] = __uint_as_float(xw.y << 16) + sigmoid_f(a[2]) * p[2]; r[3] = __uint_as_float(xw.y & 0xffff0000u) + sigmoid_f(a[3]) * p[3];
                        *(f32x4*)(xo + o2) = r; }
                asm volatile("" ::: "memory"); }
    }
};
__device__ __forceinline__ float gelu_tanh_f(float x) { const float y = 0.7978845608028654f * (x + 0.044715f * x * x * x); const float t = 1.0f - 2.0f * __builtin_amdgcn_rcpf(1.0f + __builtin_amdgcn_exp2f(2.8853900817779268f * y)); return 0.5f * x * (1.0f + t); }
struct EpiInProj {
    static constexpr bool PERM = true, AFTER_DRAIN = false;
    bf16_t* Hb; const int* pos;
    __device__ __forceinline__ void operator()(const f32x4 (&acc)[2][2][4][2], const Unit& u, int wr, int wc, int fr, int fq) const {
        constexpr float INVF[16] = {1.000000000e+00f, 4.403665960e-01f, 1.939227432e-01f, 8.539710194e-02f, 3.760603070e-02f, 1.656043902e-02f, 7.292664610e-03f, 3.211445874e-03f,
                                    1.414213562e-03f, 6.227723788e-04f, 2.742481884e-04f, 1.207697351e-04f, 5.318296098e-05f, 2.341999971e-05f, 1.031338616e-05f, 4.541670478e-06f};
        const int pn = u.pn, row0 = u.pm * BM + wr * 64 + fr, cw = wc * 32 + 8 * fq;
        if (pn >= 16) {
#pragma unroll
            for (int ai = 0; ai < 2; ++ai)
#pragma unroll
                for (int m = 0; m < 4; ++m) { const int row = row0 + ai * HALF + m * 16;
#pragma unroll
                    for (int bj = 0; bj < 2; ++bj) { const int ch0 = (pn - 16) * 256 + bj * HALF + cw;
                        bf16_t* p = Hb + (size_t)16384 * 4096 + ((size_t)((row >> 13) * 96 + (ch0 >> 4)) * 8192 + (row & 8191)) * 16 + (ch0 & 15);
                        float h[8];
#pragma unroll
                        for (int e = 0; e < 8; ++e) h[e] = gelu_tanh_f(acc[ai][bj][m][e >> 2][e & 3]);
                        u32x4 w; w.x = cvt_pk_bf16(h[0], h[1]); w.y = cvt_pk_bf16(h[2], h[3]); w.z = cvt_pk_bf16(h[4], h[5]); w.w = cvt_pk_bf16(h[6], h[7]); *(u32x4*)p = w; } }
            return;
        }
        bf16_t* base; int ld, c0;
        if (pn < 6) { base = Hb; ld = 1536; c0 = pn * 256; }
        else if (pn < 8) { base = Hb + (size_t)16384 * 1536; ld = 512; c0 = (pn - 6) * 256; }
        else if (pn < 10) { base = Hb + (size_t)16384 * 2048; ld = 512; c0 = (pn - 8) * 256; }
        else { base = Hb + (size_t)16384 * 2560; ld = 1536; c0 = (pn - 10) * 256; }
        const bool rot = (pn < 8) && (wc == 0);
        const float sgn = (fq < 2) ? -1.0f : 1.0f;
#pragma unroll
        for (int ai = 0; ai < 2; ++ai)
#pragma unroll
            for (int m = 0; m < 4; ++m) { const int row = row0 + ai * HALF + m * 16; bf16_t* rowp = base + (size_t)row * ld + c0 + cw;
                float cs[8], sn[8];
                if (rot) { const float ps = (float)pos[row];
#pragma unroll
                    for (int e = 0; e < 8; ++e) { const float ang = ps * ((fq & 1) ? INVF[8 + e] : INVF[e]); const float kq = rintf(ang * 0.15915494309189535f);
                        float r1 = fmaf(-kq, 6.28125f, ang); r1 = fmaf(-kq, 1.9353071795864769e-3f, r1); cs[e] = __cosf(r1); sn[e] = __sinf(r1) * sgn; } }
#pragma unroll
                for (int bj = 0; bj < 2; ++bj) { float v[8];
#pragma unroll
                    for (int e = 0; e < 8; ++e) v[e] = acc[ai][bj][m][e >> 2][e & 3];
                    if (rot) {
#pragma unroll
                        for (int e = 0; e < 8; ++e) { const float pt = __shfl_xor(v[e], 32); v[e] = v[e] * cs[e] + pt * sn[e]; } }
                    u32x4 w; w.x = cvt_pk_bf16(v[0], v[1]); w.y = cvt_pk_bf16(v[2], v[3]); w.z = cvt_pk_bf16(v[4], v[5]); w.w = cvt_pk_bf16(v[6], v[7]);
                    *(u32x4*)(rowp + bj * HALF) = w; } }
    }
};
struct EpiLru {
    static constexpr bool PERM = true, AFTER_DRAIN = false;
    const bf16_t* xc; bf16_t* la; bf16_t* uo; const float* br; const float* bi; const float* sp;
    __device__ __forceinline__ void operator()(const f32x4 (&acc)[2][2][4][2], const Unit& u, int wr, int wc, int fr, int fq) const {
        const int row0 = u.pm * BM + wr * 64 + fr, ch0 = u.pn * HALF + wc * 32 + 8 * fq;
#pragma unroll
        for (int ai = 0; ai < 2; ++ai)
#pragma unroll
            for (int m = 0; m < 4; ++m) { const int row = row0 + ai * HALF + m * 16; const size_t off = (size_t)row * 1536 + ch0;
                const size_t ob = ((size_t)((row >> 13) * 96 + (ch0 >> 4)) * 8192 + (row & 8191)) * 16 + (ch0 & 15);
                const u32x4 xv = *(const u32x4*)(xc + off); unsigned lw[4], uw[4];
#pragma unroll
                for (int n = 0; n < 2; ++n) { const f32x4 brv = *(const f32x4*)(br + ch0 + 4 * n), biv = *(const f32x4*)(bi + ch0 + 4 * n), spv = *(const f32x4*)(sp + ch0 + 4 * n); float lv[4], uv[4];
#pragma unroll
                    for (int j = 0; j < 4; ++j) { const unsigned xw = xv[2 * n + (j >> 1)]; const float x = __uint_as_float((j & 1) ? (xw & 0xffff0000u) : (xw << 16));
                        const float r = sigmoid_f(acc[ai][0][m][n][j] + brv[j]), ig = sigmoid_f(acc[ai][1][m][n][j] + biv[j]);
                        const float l = spv[j] * r, a = __expf(l); lv[j] = 1.0f - a; uv[j] = __builtin_amdgcn_sqrtf(fmaxf(1.0f - a * a, 0.f)) * (ig * x); }
                    lw[2 * n] = cvt_pk_bf16(lv[0], lv[1]); lw[2 * n + 1] = cvt_pk_bf16(lv[2], lv[3]); uw[2 * n] = cvt_pk_bf16(uv[0], uv[1]); uw[2 * n + 1] = cvt_pk_bf16(uv[2], uv[3]); }
                *(u32x4*)(la + ob) = (u32x4){lw[0], lw[1], lw[2], lw[3]}; *(u32x4*)(uo + ob) = (u32x4){uw[0], uw[1], uw[2], uw[3]};
                asm volatile("" ::: "memory"); }
    }
};

template <class Epi, class Sched, bool ALIGN_EPI = false, bool SP2 = false>
__device__ __forceinline__ void gemm_phase(PG8_LAS unsigned char* lds, const Gemm g, const Sched& S, const Epi& E) {
    int tid_ = threadIdx.x; asm volatile("" : "+v"(tid_));
    const int tid = tid_, wid = __builtin_amdgcn_readfirstlane(tid >> 6), lane = tid & 63, wr = wid >> 2, wc = wid & 3, fr = lane & 15, fq = lane >> 4;
    const int K = g.K, nt = K / BK;
    unsigned voffA[2], voffB[2];
#pragma unroll
    for (int i = 0; i < 2; ++i) { int R, C; stage_rc(tid * 16 + i * 8192, R, C); const int Rb = Epi::PERM ? ((R & ~31) + perm32(R & 31)) : R;
        voffA[i] = g.ablk == 2 ? (unsigned)(R * 64 + C) * 2u : g.ablk ? (unsigned)((C >> 4) * (8192 * 16) + R * 16 + (C & 15)) * 2u : (unsigned)(R * g.lda + C) * 2u; voffB[i] = (unsigned)(Rb * K + C) * 2u; }
    const size_t kstepB = (size_t)(BK * 2), kstepA = g.ablk == 2 ? (size_t)g.M * 64 * 2 : g.ablk ? (size_t)4 * 8192 * 16 * 2 : (size_t)(BK * 2);
    const size_t hstepA = g.ablk == 2 ? (size_t)HALF * 64 * 2 : g.ablk ? (size_t)HALF * 16 * 2 : (size_t)HALF * g.lda * 2, hstepB = (size_t)HALF * K * 2;
    const size_t tstepA = 2 * hstepA, tstepB = 2 * hstepB;
    const unsigned ldsw = (unsigned)wid * 1024u;
    const int aoff = lds_byte(wr * 64 + fr, fq * 8), boff = lds_byte(wc * 32 + fr, fq * 8);
#define PG8_SA(b, h) (((b) * 2 + (h)) * HTB)
#define PG8_SB(b, h) ((4 + (b) * 2 + (h)) * HTB)
#define PG8_STAGE(bufoff, gbase, voff) do { _Pragma("unroll") for (int _i = 0; _i < 2; ++_i) \
        __builtin_amdgcn_global_load_lds((const unsigned*)((const char*)(gbase) + (voff)[_i]), (PG8_LAS unsigned*)(lds + (bufoff) + ldsw + _i * 8192), 16, 0, 0); } while (0)
#define PG8_LDA(dst, b, h) do { _Pragma("unroll") for (int m = 0; m < 4; ++m) _Pragma("unroll") for (int k = 0; k < 2; ++k) dst[m][k] = *(const PG8_LAS bf16x8*)(lds + PG8_SA(b, h) + aoff + m * 2048 + k * 1024); } while (0)
#define PG8_LDB(dst, b, h) do { _Pragma("unroll") for (int n = 0; n < 2; ++n) _Pragma("unroll") for (int k = 0; k < 2; ++k) dst[n][k] = *(const PG8_LAS bf16x8*)(lds + PG8_SB(b, h) + boff + n * 2048 + k * 1024); } while (0)
#define PG8_MMA(ai, bj, At, Bt) do { __builtin_amdgcn_s_setprio(1); _Pragma("unroll") for (int m = 0; m < 4; ++m) _Pragma("unroll") for (int n = 0; n < 2; ++n) _Pragma("unroll") for (int k = 0; k < 2; ++k) \
        acc[ai][bj][m][n] = __builtin_amdgcn_mfma_f32_16x16x32_bf16(Bt[n][k], At[m][k], acc[ai][bj][m][n], 0, 0, 0); __builtin_amdgcn_s_setprio(0); } while (0)
#define PG8_WAIT_V(n) asm volatile("s_waitcnt vmcnt(" #n ")" ::: "memory")
#define PG8_WAIT_L(n) asm volatile("s_waitcnt lgkmcnt(" #n ")" ::: "memory")
#define PG8_BAR __builtin_amdgcn_s_barrier()
#define PG8_SCHED __builtin_amdgcn_sched_barrier(0)
    Unit cur, nxt; int ui = 0;
    if (!S.next(0, cur)) return;
    f32x4 acc[2][2][4][2];
#pragma unroll
    for (int a = 0; a < 2; ++a)
#pragma unroll
        for (int b = 0; b < 2; ++b)
#pragma unroll
            for (int m = 0; m < 4; ++m)
#pragma unroll
                for (int n = 0; n < 2; ++n) acc[a][b][m][n] = (f32x4){0.f, 0.f, 0.f, 0.f};
    bf16x8 At[4][2], B0[2][2], B1[2][2];
    const char* cA = (const char*)g.A + (g.ablk == 2 ? (size_t)cur.pm * 256 * 64 * 2 : g.ablk ? ((size_t)(cur.pm >> 5) * 128 * 8192 * 16 + (size_t)(cur.pm & 31) * 256 * 16) * 2 : (size_t)cur.pm * tstepA + (size_t)(cur.pn >> 1) * g.apn2 * 2); const char* cB = (const char*)g.Bt + (size_t)cur.pn * tstepB;
    S.a_ready(cur);
    if constexpr (SP2) {
        PG8_STAGE(PG8_SB(0, 0), cB, voffB); PG8_STAGE(PG8_SB(0, 1), cB + hstepB, voffB); PG8_STAGE(PG8_SA(0, 0), cA, voffA); PG8_STAGE(PG8_SA(0, 1), cA + hstepA, voffA);
        if (wr == 1) PG8_BAR;
        PG8_WAIT_V(2); PG8_BAR;
        PG8_STAGE(PG8_SB(1, 0), cB + kstepB, voffB); PG8_STAGE(PG8_SA(1, 0), cA + kstepA, voffA); PG8_STAGE(PG8_SB(1, 1), cB + hstepB + kstepB, voffB);
        PG8_WAIT_V(6); PG8_BAR;
    } else {
        PG8_STAGE(PG8_SB(0, 0), cB, voffB); PG8_STAGE(PG8_SA(0, 0), cA, voffA); PG8_STAGE(PG8_SB(0, 1), cB + hstepB, voffB); PG8_STAGE(PG8_SA(0, 1), cA + hstepA, voffA);
        if (wr == 1) PG8_BAR;
        PG8_WAIT_V(4); PG8_BAR;
        PG8_STAGE(PG8_SB(1, 0), cB + kstepB, voffB); PG8_STAGE(PG8_SA(1, 0), cA + kstepA, voffA); PG8_STAGE(PG8_SB(1, 1), cB + hstepB + kstepB, voffB);
        PG8_WAIT_V(6); PG8_BAR;
    }
    for (;;) {
        const bool has_next = S.next(ui + 1, nxt);
        const char* nA = has_next ? (const char*)g.A + (g.ablk == 2 ? (size_t)nxt.pm * 256 * 64 * 2 : g.ablk ? ((size_t)(nxt.pm >> 5) * 128 * 8192 * 16 + (size_t)(nxt.pm & 31) * 256 * 16) * 2 : (size_t)nxt.pm * tstepA + (size_t)(nxt.pn >> 1) * g.apn2 * 2) : cA; const char* nB = has_next ? (const char*)g.Bt + (size_t)nxt.pn * tstepB : cB;
        for (int t = 0; t < nt; t += 2) {
            const bool last = (t == nt - 2);
            const char* a1 = cA + (size_t)(t + 1) * kstepA;
            const char* a2 = last ? nA : cA + (size_t)(t + 2) * kstepA; const char* b2 = last ? nB : cB + (size_t)(t + 2) * kstepB;
            const char* a3 = a2 + kstepA; const char* b3 = b2 + kstepB;
            if (last && has_next) S.a_ready(nxt);
            if constexpr (SP2) {
            PG8_LDB(B0, 0, 0); PG8_LDB(B1, 0, 1); PG8_SCHED; PG8_LDA(At, 0, 0); PG8_STAGE(PG8_SA(1, 1), a1 + hstepA, voffA);
            PG8_WAIT_V(8); PG8_WAIT_L(0); PG8_BAR; PG8_MMA(0, 0, At, B0); PG8_MMA(0, 1, At, B1); PG8_BAR; PG8_SCHED;
            PG8_LDA(At, 0, 1); PG8_STAGE(PG8_SB(0, 0), b2, voffB); PG8_STAGE(PG8_SB(0, 1), b2 + hstepB, voffB); PG8_STAGE(PG8_SA(0, 0), a2, voffA);
            PG8_WAIT_V(8); PG8_WAIT_L(0); PG8_BAR; PG8_MMA(1, 0, At, B0); PG8_MMA(1, 1, At, B1); PG8_BAR; PG8_SCHED;
            PG8_LDB(B0, 1, 0); PG8_LDB(B1, 1, 1); PG8_SCHED; PG8_LDA(At, 1, 0); PG8_STAGE(PG8_SA(0, 1), a2 + hstepA, voffA);
            PG8_WAIT_V(8); PG8_WAIT_L(0); PG8_BAR; PG8_MMA(0, 0, At, B0); PG8_MMA(0, 1, At, B1); PG8_BAR; PG8_SCHED;
            PG8_LDA(At, 1, 1); PG8_STAGE(PG8_SB(1, 0), b3, voffB); PG8_STAGE(PG8_SB(1, 1), b3 + hstepB, voffB); PG8_STAGE(PG8_SA(1, 0), a3, voffA);
            PG8_WAIT_V(8); PG8_WAIT_L(0); PG8_BAR; PG8_MMA(1, 0, At, B0); PG8_MMA(1, 1, At, B1); PG8_BAR; PG8_SCHED;
            } else {
            PG8_LDB(B0, 0, 0); PG8_SCHED; PG8_LDA(At, 0, 0); PG8_STAGE(PG8_SA(1, 1), a1 + hstepA, voffA);
            PG8_WAIT_L(8); PG8_BAR; PG8_WAIT_L(0); PG8_MMA(0, 0, At, B0); PG8_BAR; PG8_SCHED;
            PG8_LDB(B1, 0, 1); PG8_STAGE(PG8_SB(0, 0), b2, voffB);
            PG8_BAR; PG8_WAIT_L(0); PG8_MMA(0, 1, At, B1); PG8_BAR;
            PG8_LDA(At, 0, 1); PG8_STAGE(PG8_SA(0, 0), a2, voffA);
            PG8_BAR; PG8_WAIT_L(0); PG8_MMA(1, 0, At, B0); PG8_BAR; PG8_SCHED;
            PG8_STAGE(PG8_SB(0, 1), b2 + hstepB, voffB);
            PG8_WAIT_V(6); PG8_BAR; PG8_MMA(1, 1, At, B1); PG8_BAR;
            PG8_LDB(B0, 1, 0); PG8_SCHED; PG8_LDA(At, 1, 0); PG8_STAGE(PG8_SA(0, 1), a2 + hstepA, voffA);
            PG8_WAIT_L(8); PG8_BAR; PG8_WAIT_L(0); PG8_MMA(0, 0, At, B0); PG8_BAR; PG8_SCHED;
            PG8_LDB(B1, 1, 1); PG8_STAGE(PG8_SB(1, 0), b3, voffB);
            PG8_BAR; PG8_WAIT_L(0); PG8_MMA(0, 1, At, B1); PG8_BAR;
            PG8_LDA(At, 1, 1); PG8_STAGE(PG8_SA(1, 0), a3, voffA);
            PG8_BAR; PG8_WAIT_L(0); PG8_MMA(1, 0, At, B0); PG8_BAR; PG8_SCHED;
            PG8_STAGE(PG8_SB(1, 1), b3 + hstepB, voffB);
            PG8_WAIT_V(6); PG8_BAR; PG8_MMA(1, 1, At, B1); PG8_BAR;
            }
        }
        if constexpr (ALIGN_EPI) { if (wr == 0) PG8_BAR; }
        if constexpr (!Epi::AFTER_DRAIN) { E(acc, cur, wr, wc, fr, fq); S.done(cur); } else { if (has_next) E.first(acc, cur, wr, wc, fr, fq); }
        if (!has_next) break;
#pragma unroll
        for (int a = 0; a < 2; ++a)
#pragma unroll
            for (int b = 0; b < 2; ++b)
#pragma unroll
                for (int m = 0; m < 4; ++m)
#pragma unroll
                    for (int n = 0; n < 2; ++n) acc[a][b][m][n] = (f32x4){0.f, 0.f, 0.f, 0.f};
        cur = nxt; cA = nA; cB = nB; ++ui;
        if constexpr (ALIGN_EPI) { if (wr == 1) PG8_BAR; }
    }
    PG8_WAIT_V(0);
    if constexpr (!ALIGN_EPI) { if (wr == 0) PG8_BAR; }
    PG8_BAR;
    if constexpr (Epi::AFTER_DRAIN) { E.fused(acc, cur, wr, wc, fr, fq, lds, wid, lane); S.done(cur); }
#undef PG8_SA
#undef PG8_SB
#undef PG8_STAGE
#undef PG8_LDA
#undef PG8_LDB
#undef PG8_MMA
#undef PG8_WAIT_V
#undef PG8_WAIT_L
#undef PG8_BAR
#undef PG8_SCHED
}
}

constexpr int NWAVES = 8, NTHREADS = NWAVES * 64;
constexpr int SEQ = 8192, NB = 2, M = NB * SEQ, D = 2048, FF = 5632, NIN = 5632, LW = 1536;
constexpr size_t SEC_K = (size_t)16384 * 1536, SEC_V = (size_t)16384 * 2048, SEC_XB = (size_t)16384 * 2560, SEC_YG = (size_t)16384 * 4096;
constexpr float LN_EPS = 1e-5f, ALPHA = 1.189207115002721f;
constexpr size_t MiB = 1u << 20;
constexpr size_t WS_BAR = 0, WS_CNT = 65536  , WS_LSE = 1 * MiB, WS_SP = 2 * MiB, WS_SLOT = 2 * MiB + 262144  , WS_TS = 4 * MiB - 65536;
constexpr size_t WS_WFGU = 4 * MiB, WS_WFD = 48 * MiB;
constexpr size_t WS_WIN = 70 * MiB, WS_WOUT = 92 * MiB, WS_WPG = 100 * MiB, WS_WPP = 108 * MiB, WS_WRG = 109 * MiB, WS_PB = 111 * MiB;
constexpr size_t WS_XB = 120 * MiB;
constexpr size_t WS_H = 184 * MiB;
constexpr size_t WS_XC = 360 * MiB, WS_LA = 408 * MiB, WS_U = 456 * MiB, WS_END = 504 * MiB;
constexpr int LDS_BYTES = 147456;

#define LAS __attribute__((address_space(3)))
typedef unsigned short bf16;
typedef unsigned v4u __attribute__((ext_vector_type(4)));
typedef unsigned v2u __attribute__((ext_vector_type(2)));
typedef float f32x4 __attribute__((ext_vector_type(4)));
#define LDS_WAIT() asm volatile("s_waitcnt lgkmcnt(0)" ::: "memory")
__device__ __forceinline__ unsigned f2bf(float f) { unsigned u = __builtin_bit_cast(unsigned, f); return (u + 0x7fffu + ((u >> 16) & 1u)) >> 16; }
__device__ __forceinline__ unsigned pk2(float lo, float hi) { return f2bf(lo) | (f2bf(hi) << 16); }
__device__ __forceinline__ float bflo(unsigned w) { return __uint_as_float(w << 16); }
__device__ __forceinline__ float bfhi(unsigned w) { return __uint_as_float(w & 0xffff0000u); }
__device__ __forceinline__ float bf1(bf16 h) { return __uint_as_float((unsigned)h << 16); }
__device__ __forceinline__ float wave_sum(float v) {
#pragma unroll
    for (int o = 1; o < 64; o <<= 1) v += __shfl_xor(v, o);
    return v;
}
__device__ __forceinline__ float wave_max(float v) {
#pragma unroll
    for (int o = 1; o < 64; o <<= 1) v = fmaxf(v, __shfl_xor(v, o));
    return v;
}
__device__ __forceinline__ float gelu_tanh(float x) {
    const float y = 0.7978845608028654f * (x + 0.044715f * x * x * x);
    const float t = 1.0f - 2.0f * __builtin_amdgcn_rcpf(1.0f + __expf(2.0f * y));
    return 0.5f * x * (1.0f + t);
}

struct Args { const float* in[26]; float* out; unsigned char* ws; int ph_lo, ph_hi; };

__device__ __forceinline__ void tr_item(const float* W, int N, int k0, int n0, bf16* WT, int drow0, int ldt, int dcol0, LAS float* scr, int lane, bool nts = false) {
    float tv[32];
#pragma unroll
    for (int i = 0; i < 32; ++i) tv[i] = __builtin_nontemporal_load(&W[(size_t)(k0 + 2 * i + (lane >> 5)) * N + n0 + (lane & 31)]);
#pragma unroll
    for (int i = 0; i < 32; ++i) scr[(2 * i + (lane >> 5)) * 33 + (lane & 31)] = tv[i];
    LDS_WAIT(); asm volatile("" ::: "memory");
    const int c = lane & 7;
#pragma unroll
    for (int j = 0; j < 4; ++j) { const int n = (lane >> 3) + 8 * j; const LAS float* s = scr + (8 * c) * 33 + n;
        v4u o; o.x = pk2(s[0 * 33], s[1 * 33]); o.y = pk2(s[2 * 33], s[3 * 33]); o.z = pk2(s[4 * 33], s[5 * 33]); o.w = pk2(s[6 * 33], s[7 * 33]);
        if (nts) __builtin_nontemporal_store(o, (v4u*)(WT + (size_t)(drow0 + n) * ldt + dcol0 + 8 * c)); else *(v4u*)(WT + (size_t)(drow0 + n) * ldt + dcol0 + 8 * c) = o; }
    LDS_WAIT(); asm volatile("" ::: "memory");
}
__device__ __forceinline__ void tr_matrix_item(const float* W, int K, int N, bf16* WT, int mode, int item, LAS float* scr, int lane, bool nts = false) {
    const int nblk = N / 32, kb = item / nblk, nb = item % nblk, k0 = 64 * kb, n0 = 32 * nb;
    int drow0 = n0; if (mode) drow0 = 256 * (n0 >> 7) + (n0 & 127) + (mode == 2 ? 128 : 0);
    tr_item(W, N, k0, n0, WT, drow0, K, k0, scr, lane, nts);
}
constexpr int IT_FF = (D / 64) * (FF / 32);
__device__ __forceinline__ void convert_ffn(const float* wg, const float* wu, const float* wd, unsigned char* ws, LAS float* scr, int it_lo, int it_hi, int gw, int NGW, int lane, bool late = false) {
    for (int it = it_lo + gw; it < it_hi; it += NGW) {
        int r = it;
        if (r < IT_FF) { tr_matrix_item(wg, D, FF, (bf16*)(ws + WS_WFGU), 1, r, scr, lane, late); continue; } r -= IT_FF;
        if (r < IT_FF) { tr_matrix_item(wu, D, FF, (bf16*)(ws + WS_WFGU), 2, r, scr, lane, late); continue; } r -= IT_FF;
        tr_matrix_item(wd, FF, D, (bf16*)(ws + WS_WFD), 0, r, scr, lane, true);
    }
}
__device__ __forceinline__ void convert_rest(const Args& a, LAS float* scr, int gw, int NGW, int lane) {
    unsigned char* ws = a.ws;
    constexpr int I_IN = IT_FF, I_SQ = (D / 64) * (D / 32), I_PP = (256 / 64) * (D / 32), I_RG = 24 * 8;
    for (int it = gw; it < I_IN + 2 * I_SQ + I_PP + I_RG; it += NGW) {
        int r = it;
        if (r < I_IN) { tr_matrix_item(a.in[8], D, NIN, (bf16*)(ws + WS_WIN), 0, r, scr, lane, true); continue; } r -= I_IN;
        if (r < I_SQ) { tr_matrix_item(a.in[16], D, D, (bf16*)(ws + WS_WOUT), 0, r, scr, lane, true); continue; } r -= I_SQ;
        if (r < I_SQ) { tr_matrix_item(a.in[25], D, D, (bf16*)(ws + WS_WPG), 0, r, scr, lane, true); continue; } r -= I_SQ;
        if (r < I_PP) { tr_matrix_item(a.in[24], 256, D, (bf16*)(ws + WS_WPP), 0, r, scr, lane, true); continue; } r -= I_PP;
        { const int mi = r >> 3, sub = r & 7, gate = mi / 12, g = mi % 12, kb = sub >> 2, nb = sub & 3;
          const float* W = (gate ? a.in[13] : a.in[11]) + (size_t)g * 128 * 128; bf16* WT = (bf16*)(ws + WS_WRG);
          const int drow0 = 256 * g + 128 * gate + 32 * nb;
          tr_item(W, 128, 64 * kb, 32 * nb, WT, drow0, 256, 128 * (g & 1) + 64 * kb, scr, lane);
          const int c = lane & 7;
#pragma unroll
          for (int j = 0; j < 4; ++j) { const int n = (lane >> 3) + 8 * j; *(v4u*)(WT + (size_t)(drow0 + n) * 256 + 128 * ((g & 1) ^ 1) + 64 * kb + 8 * c) = (v4u){0u, 0u, 0u, 0u}; } }
    }
}
__device__ __forceinline__ void cvt_rows(const float* src, bf16* dst, size_t n, int gtid, int gthreads) {
    for (size_t i = (size_t)gtid * 8; i < n; i += (size_t)gthreads * 32) {
        f32x4 a[4], b[4];
#pragma unroll
        for (int k = 0; k < 4; ++k) if (i + (size_t)k * gthreads * 8 < n) { a[k] = __builtin_nontemporal_load((const f32x4*)(src + i + (size_t)k * gthreads * 8)); b[k] = __builtin_nontemporal_load((const f32x4*)(src + i + (size_t)k * gthreads * 8 + 4)); }
#pragma unroll
        for (int k = 0; k < 4; ++k) if (i + (size_t)k * gthreads * 8 < n) *(v4u*)(dst + i + (size_t)k * gthreads * 8) = (v4u){pk2(a[k][0], a[k][1]), pk2(a[k][2], a[k][3]), pk2(b[k][0], b[k][1]), pk2(b[k][2], b[k][3])};
    }
}
__device__ __forceinline__ void ln_rows(float* z, bf16* xb, const float* g, const float* b, int gw, int NGW, int lane) {
    for (int m = gw; m < M; m += NGW) {
        f32x4* zr = (f32x4*)(z + (size_t)m * D) + lane; f32x4 v[8]; float s = 0.f;
#pragma unroll
        for (int j = 0; j < 8; ++j) { v[j] = zr[64 * j]; s += (v[j][0] + v[j][1]) + (v[j][2] + v[j][3]); }
        const float mean = wave_sum(s) * (1.f / D); float s2 = 0.f;
#pragma unroll
        for (int j = 0; j < 8; ++j) { v[j] = v[j] - mean; s2 += (v[j][0] * v[j][0] + v[j][1] * v[j][1]) + (v[j][2] * v[j][2] + v[j][3] * v[j][3]); }
        const float rstd = 1.f / sqrtf(wave_sum(s2) * (1.f / D) + LN_EPS);
        v2u* o8 = (v2u*)(xb + (size_t)m * D) + lane;
#pragma unroll
        for (int j = 0; j < 8; ++j) { const f32x4 gg = *((const f32x4*)g + lane + 64 * j), bb = *((const f32x4*)b + lane + 64 * j);
            const f32x4 y = v[j] * rstd * gg + bb; zr[64 * j] = y; o8[64 * j] = (v2u){pk2(y[0], y[1]), pk2(y[2], y[3])}; }
    }
}
__device__ __forceinline__ void conv_rows(const bf16* proj, const float* cw, const float* cb, bf16* xc, int gtid, int gthreads) {
    for (int it = gtid; it < (M / 4) * (LW / 8); it += gthreads) {
        const int m0 = (it / (LW / 8)) * 4, c8 = (it % (LW / 8)) * 8, t0 = m0 & (SEQ - 1);
        v4u xv[7];
#pragma unroll
        for (int j = 0; j < 7; ++j) xv[j] = (t0 - 3 + j >= 0) ? *(const v4u*)(proj + SEC_XB + (size_t)(m0 - 3 + j) * LW + c8) : (v4u){0u, 0u, 0u, 0u};
        f32x4 w[4][2];
#pragma unroll
        for (int j = 0; j < 4; ++j) { w[j][0] = *(const f32x4*)(cw + j * LW + c8); w[j][1] = *(const f32x4*)(cw + j * LW + c8 + 4); }
        const f32x4 b0 = *(const f32x4*)(cb + c8), b1 = *(const f32x4*)(cb + c8 + 4);
#pragma unroll
        for (int r = 0; r < 4; ++r) { float acc[8] = {b0[0], b0[1], b0[2], b0[3], b1[0], b1[1], b1[2], b1[3]};
#pragma unroll
            for (int j = 0; j < 4; ++j) { const v4u x = xv[r + j];
                acc[0] += w[j][0][0] * bflo(x[0]); acc[1] += w[j][0][1] * bfhi(x[0]); acc[2] += w[j][0][2] * bflo(x[1]); acc[3] += w[j][0][3] * bfhi(x[1]);
                acc[4] += w[j][1][0] * bflo(x[2]); acc[5] += w[j][1][1] * bfhi(x[2]); acc[6] += w[j][1][2] * bflo(x[3]); acc[7] += w[j][1][3] * bfhi(x[3]); }
            *(v4u*)(xc + (size_t)(m0 + r) * LW + c8) = (v4u){pk2(acc[0], acc[1]), pk2(acc[2], acc[3]), pk2(acc[4], acc[5]), pk2(acc[6], acc[7])}; }
    }
}
typedef short s16x8 __attribute__((ext_vector_type(8)));
typedef short s16x4 __attribute__((ext_vector_type(4)));
typedef float f32x16 __attribute__((ext_vector_type(16)));
typedef float f32x2_t __attribute__((ext_vector_type(2))); typedef __bf16 bf16x2_t __attribute__((ext_vector_type(2)));
__device__ __forceinline__ unsigned cvtpk(float lo, float hi) { f32x2_t v = {lo, hi}; bf16x2_t b = __builtin_convertvector(v, bf16x2_t); return __builtin_bit_cast(unsigned, b); }
__device__ __forceinline__ s16x4 vtr(LAS unsigned char* p) { return __builtin_bit_cast(s16x4, __builtin_amdgcn_ds_read_tr16_b64_v4i16((LAS s16x4*)p)); }
__device__ __forceinline__ int crow(int r, int h) { return (r & 3) + 8 * (r >> 2) + 4 * h; }
__device__ __forceinline__ void attn_mfma(bf16* hb, float* lse, LAS unsigned char* lds, int gw, int NGW, int wave, int lane) {
    LAS unsigned char* kbuf = lds + wave * 16896;
    LAS unsigned char* vbuf = kbuf + 8704;
    const int q32 = lane & 31, hh = lane >> 5;
    const int trl = (4 * hh + ((lane & 15) >> 2)) * 64 + ((lane >> 4) & 1) * 32 + (lane & 3) * 8;
    const int ckey = lane >> 4, cdc = lane & 15;
    const int kst = ckey * 272 + cdc * 16, vst = ((cdc >> 2) * 4) * 512 + ckey * 64 + (cdc & 3) * 16;
    const float C = 0.08838834764831845f * 1.4426950408889634f;
    bf16* Kg = hb + SEC_K; bf16* Vg = hb + SEC_V;
    const int G_ = NGW / NWAVES, bid_ = gw / NWAVES, xcd = bid_ & 7, nw = (G_ >> 3) * NWAVES, lw = (bid_ >> 3) * NWAVES + wave;
    for (int u = lw; u < 768 && (bid_ >> 3) < (G_ >> 3); u += nw) {
        const int qg = u & 3, rn = (u >> 2) & 63, g = u >> 8, b = xcd >> 2, hkv = xcd & 3, hq = g * 4 + hkv;
        const int dsh = 2 * g, nbsh = 6 - dsh;
        const int r = rn >> nbsh, n = rn & ((1 << nbsh) - 1);
        const size_t mq = (size_t)b * SEQ + (size_t)(((128 * n + 32 * qg + q32) << dsh) + r);
        bf16* qp = hb + mq * 1536 + hq * 128;
        const int iq = 32 * qg + q32;
        const int kt1 = qg + 4, kt0 = (n == 0) ? 4 : qg;
        v4u kr[8], vr[8];
#define ATT_LOAD(kt) do { const int km0_ = 128 * (n - 1) + 32 * (kt); _Pragma("unroll") for (int i = 0; i < 8; ++i) { \
            const size_t off_ = ((size_t)b * SEQ + (size_t)(((km0_ + ckey + 4 * i) << dsh) + r)) * 512 + hkv * 128 + 8 * cdc; kr[i] = *(const v4u*)(Kg + off_); vr[i] = *(const v4u*)(Vg + off_); } } while (0)
#define ATT_STORE() do { _Pragma("unroll") for (int i = 0; i < 8; ++i) { *(LAS v4u*)(kbuf + kst + i * 1088) = kr[i]; *(LAS v4u*)(vbuf + vst + (i >> 1) * 512 + (i & 1) * 256) = vr[i]; } } while (0)
        unsigned klist = 0; int ntile = 0;
        { const int base5 = (4 * n + qg + 1) % 5;
#pragma unroll
          for (int sg = 0; sg < 5; ++sg) { const int kt = qg + (sg - base5 + 5) % 5; if (kt >= kt0) { klist |= (unsigned)kt << (4 * ntile); ++ntile; } } }
        ATT_LOAD((int)(klist & 15u));
        s16x8 qf[8];
#pragma unroll
        for (int ks = 0; ks < 8; ++ks) qf[ks] = *(const s16x8*)(qp + 16 * ks + 8 * hh);
        f32x16 O[4];
#pragma unroll
        for (int dt = 0; dt < 4; ++dt)
#pragma unroll
            for (int e = 0; e < 16; ++e) O[dt][e] = 0.f;
        float mrun = -INFINITY, lrun = 0.f;
        ATT_STORE();
        for (int ti = 0; ti < ntile; ++ti) {
            const int kt = (int)((klist >> (4 * ti)) & 15u);
            asm volatile("" ::: "memory");
            if (ti + 1 < ntile) ATT_LOAD((int)((klist >> (4 * ti + 4)) & 15u));
            f32x16 S;
#pragma unroll
            for (int e = 0; e < 16; ++e) S[e] = 0.f;
#pragma unroll
            for (int ks = 0; ks < 8; ++ks) { const s16x8 kf = *(const LAS s16x8*)(kbuf + q32 * 272 + 32 * ks + 16 * hh); S = __builtin_amdgcn_mfma_f32_32x32x16_bf16(kf, qf[ks], S, 0, 0, 0); }
            float t[16]; float mt = -INFINITY;
#pragma unroll
            for (int e = 0; e < 16; ++e) t[e] = S[e] * C;
            if (kt == qg || kt == kt1) {
#pragma unroll
                for (int e = 0; e < 16; ++e) { const int j = 32 * kt + crow(e, hh);
                    if (kt == qg ? (j < iq) : (j > iq + 128)) t[e] = -INFINITY; } }
#pragma unroll
            for (int e = 0; e < 16; ++e) mt = fmaxf(mt, t[e]);
            mt = fmaxf(mt, __shfl_xor(mt, 32));
            const float mnew = fmaxf(mrun, mt), alpha = __builtin_amdgcn_exp2f(mrun - mnew);
            float ps = 0.f;
#pragma unroll
            for (int e = 0; e < 16; ++e) { t[e] = __builtin_amdgcn_exp2f(t[e] - mnew); ps += t[e]; }
            lrun = lrun * alpha + ps; mrun = mnew;
            if (ti > 0 && __builtin_amdgcn_ballot_w64(alpha != 1.0f) != 0ull) {
#pragma unroll
                for (int dt = 0; dt < 4; ++dt) O[dt] = O[dt] * alpha; }
            s16x8 pb[2];
#pragma unroll
            for (int s = 0; s < 2; ++s) { v4u w; w[0] = cvtpk(t[8 * s], t[8 * s + 1]); w[1] = cvtpk(t[8 * s + 2], t[8 * s + 3]); w[2] = cvtpk(t[8 * s + 4], t[8 * s + 5]); w[3] = cvtpk(t[8 * s + 6], t[8 * s + 7]); pb[s] = __builtin_bit_cast(s16x8, w); }
#pragma unroll
            for (int dt = 0; dt < 4; ++dt)
#pragma unroll
                for (int s = 0; s < 2; ++s) { const s16x4 lo = vtr(vbuf + (dt * 4 + 2 * s) * 512 + trl), hi = vtr(vbuf + (dt * 4 + 2 * s + 1) * 512 + trl);
                    const s16x8 vf = {lo[0], lo[1], lo[2], lo[3], hi[0], hi[1], hi[2], hi[3]};
                    O[dt] = __builtin_amdgcn_mfma_f32_32x32x16_bf16(vf, pb[s], O[dt], 0, 0, 0); }
            asm volatile("" ::: "memory");
            if (ti + 1 < ntile) ATT_STORE();
        }
#undef ATT_LOAD
#undef ATT_STORE
        const float ltot = lrun + __shfl_xor(lrun, 32), inv = 1.0f / ltot;
#pragma unroll
        for (int dt = 0; dt < 4; ++dt)
#pragma unroll
            for (int rg = 0; rg < 4; ++rg) { const int d0 = 32 * dt + 8 * rg + 4 * hh;
                *(v2u*)(qp + d0) = (v2u){cvtpk(O[dt][4 * rg] * inv, O[dt][4 * rg + 1] * inv), cvtpk(O[dt][4 * rg + 2] * inv, O[dt][4 * rg + 3] * inv)}; }
        if (hh == 0) lse[mq * 12 + hq] = (mrun + __builtin_amdgcn_logf(ltot)) * 0.6931471805599453f;
    }
}
__device__ __forceinline__ void merge_rows(const bf16* proj, const float* lse, bf16* cat, int gtid, int gthreads) {
    for (int it0 = gtid; it0 < M * 64; it0 += 4 * gthreads) {
        v4u o[4][3]; float l[4][3];
#pragma unroll
        for (int k = 0; k < 4; ++k) { const int it = min(it0 + k * gthreads, M * 64 - 1), m = it >> 6, h = (it >> 4) & 3, c8 = (it & 15) * 8;
            const bf16* qp = proj + (size_t)m * 1536 + h * 128 + c8;
#pragma unroll
            for (int g = 0; g < 3; ++g) { l[k][g] = lse[(size_t)m * 12 + 4 * g + h]; o[k][g] = *(const v4u*)(qp + 512 * g); } }
#pragma unroll
        for (int k = 0; k < 4; ++k) { const int it = it0 + k * gthreads, m = it >> 6, h = (it >> 4) & 3, c8 = (it & 15) * 8; if (it >= M * 64) break;
            const float mx = fmaxf(fmaxf(l[k][0], l[k][1]), l[k][2]); float w0 = __expf(l[k][0] - mx), w1 = __expf(l[k][1] - mx), w2 = __expf(l[k][2] - mx);
            const float inv = 1.0f / (w0 + w1 + w2); w0 *= inv; w1 *= inv; w2 *= inv;
            v4u r;
#pragma unroll
            for (int e = 0; e < 4; ++e) r[e] = cvtpk(w0 * bflo(o[k][0][e]) + w1 * bflo(o[k][1][e]) + w2 * bflo(o[k][2][e]), w0 * bfhi(o[k][0][e]) + w1 * bfhi(o[k][1][e]) + w2 * bfhi(o[k][2][e]));
            *(v4u*)(cat + (((size_t)((m >> 13) * 128 + h * 8 + (c8 >> 4)) * SEQ + (m & (SEQ - 1))) * 16 + (c8 & 15))) = r; }
    }
}
__device__ __forceinline__ void scan_items(const bf16* ca, const bf16* uu, const bf16* yg, bf16* cat, LAS float* sm, int G, int bid, int tid, unsigned long long* tsp) {
    const int half = tid & 1, sl = tid >> 1, ce = half * 8;
    LAS float* sP = sm; LAS float* sH = sm + 4096; LAS float* gP = sm + 8192; LAS float* gH = sm + 8192 + 512;
    const int slot = bid >> 3, nslot = G >> 3;
    for (int it_ = slot; it_ < 24; it_ += nslot) {
        const int item = (bid & 7) * 24 + it_;
        const int b = item / (LW / 16), cb = item % (LW / 16);
        const size_t o0 = ((size_t)item * SEQ + sl * 32) * 16 + ce;
        const bf16* cp = ca + o0; const bf16* up = uu + o0; const bf16* yp = yg + o0;
        float P[8], H[8];
#pragma unroll
        for (int e = 0; e < 8; ++e) { P[e] = 1.f; H[e] = 0.f; }
#pragma unroll 8
        for (int t = 0; t < 32; ++t) { const v4u cv = *(const v4u*)(cp + t * 16), uv = *(const v4u*)(up + t * 16);
#pragma unroll
            for (int e = 0; e < 4; ++e) { const float a0 = 1.0f - bflo(cv[e]), a1 = 1.0f - bfhi(cv[e]); H[2 * e] = a0 * H[2 * e] + bflo(uv[e]); H[2 * e + 1] = a1 * H[2 * e + 1] + bfhi(uv[e]); P[2 * e] *= a0; P[2 * e + 1] *= a1; } }
#pragma unroll
        for (int e = 0; e < 8; ++e) { sP[sl * 16 + ce + e] = P[e]; sH[sl * 16 + ce + e] = H[e]; }
        __syncthreads();
        { const int ch = tid & 15, grp = tid >> 4; float p = 1.f, h = 0.f;
#pragma unroll
          for (int k = 0; k < 8; ++k) { const float pp = sP[(grp * 8 + k) * 16 + ch]; h = pp * h + sH[(grp * 8 + k) * 16 + ch]; p *= pp; }
          gP[grp * 16 + ch] = p; gH[grp * 16 + ch] = h; }
        __syncthreads();
        float h[8];
#pragma unroll
        for (int e = 0; e < 8; ++e) h[e] = 0.f;
        const int grp = sl >> 3;
        for (int gg = 0; gg < grp; ++gg)
#pragma unroll
            for (int e = 0; e < 8; ++e) h[e] = gP[gg * 16 + ce + e] * h[e] + gH[gg * 16 + ce + e];
        for (int s2 = grp * 8; s2 < sl; ++s2)
#pragma unroll
            for (int e = 0; e < 8; ++e) h[e] = sP[s2 * 16 + ce + e] * h[e] + sH[s2 * 16 + ce + e];
        const size_t m0 = (size_t)b * SEQ + sl * 32;
        if (tsp && bid == 0 && tid == 0) tsp[24] = __builtin_amdgcn_s_memrealtime();
#pragma unroll 8
        for (int t = 0; t < 32; ++t) { const v4u cv = *(const v4u*)(cp + t * 16), uv = *(const v4u*)(up + t * 16), yv = *(const v4u*)(yp + t * 16);
            v4u o;
#pragma unroll
            for (int e = 0; e < 4; ++e) { h[2 * e] = (1.0f - bflo(cv[e])) * h[2 * e] + bflo(uv[e]); h[2 * e + 1] = (1.0f - bfhi(cv[e])) * h[2 * e + 1] + bfhi(uv[e]);
                o[e] = cvtpk(h[2 * e] * bflo(yv[e]), h[2 * e + 1] * bfhi(yv[e])); }
            *(v4u*)(cat + (((size_t)(b * 128 + 32 + cb) * SEQ + sl * 32 + t) * 16 + ce)) = o; }
        __syncthreads();
    }
}

__device__ __forceinline__ void grid_bar(unsigned* cnt, unsigned target) {
    asm volatile("s_waitcnt vmcnt(0)" ::: "memory");
    __syncthreads();
    if (threadIdx.x == 0) {
        __builtin_amdgcn_fence(__ATOMIC_RELEASE, "agent");
        __hip_atomic_fetch_add(cnt, 1u, __ATOMIC_RELAXED, __HIP_MEMORY_SCOPE_AGENT);
        unsigned spins = 0;
        while (__hip_atomic_load(cnt, __ATOMIC_RELAXED, __HIP_MEMORY_SCOPE_AGENT) < target && ++spins < (1u << 24)) __builtin_amdgcn_s_sleep(1);
        __builtin_amdgcn_fence(__ATOMIC_ACQUIRE, "agent");
        asm volatile("s_waitcnt vmcnt(0)" ::: "memory");
    }
    __syncthreads();
}
#ifndef MK_N_LAUNCHES
#define MK_N_LAUNCHES 1
#endif
constexpr int NPHASES = 14;
constexpr int W2_EARLY = 10240;
__global__ void __launch_bounds__(NTHREADS, 2) fwd_kernel(Args a) {
    extern __shared__ __attribute__((aligned(16))) unsigned char lds_raw[];
    LAS unsigned char* lds = (LAS unsigned char*)lds_raw;
    const int G = gridDim.x, bid = blockIdx.x, NGW = G * NWAVES, gthreads = G * NTHREADS;
#define PHASE_VARS int tid = threadIdx.x; asm volatile("" : "+v"(tid)); const int lane = tid & 63, wave = __builtin_amdgcn_readfirstlane(tid >> 6), gw = bid * NWAVES + wave, gtid = bid * NTHREADS + tid; \
    LAS float* scr = (LAS float*)(lds + wave * 16384); (void)lane; (void)gw; (void)gtid; (void)scr;
    unsigned char* ws = a.ws;
    bf16* XB = (bf16*)(ws + WS_XB); bf16* HB = (bf16*)(ws + WS_H); float* PP = (float*)(ws + WS_H);
    bf16* XC = (bf16*)(ws + WS_XC); bf16* LA = (bf16*)(ws + WS_LA); bf16* UU = (bf16*)(ws + WS_U); float* LSE = (float*)(ws + WS_LSE);
    const float* x = a.in[0]; float* out = a.out;
    const int lo = a.ph_lo, hi = a.ph_hi;
#ifndef PHASE_MASK
#define PHASE_MASK 0xffff
#endif
#define IN(k) (((PHASE_MASK >> (k)) & 1) && lo <= (k) && (k) < hi)
#ifdef PROBE_K
#define SCAN_TSP ((unsigned long long*)(ws + WS_TS))
#define STAMP(k) do { if (bid == 0 && threadIdx.x == 0) ((unsigned long long*)(ws + WS_TS))[(k) + 1] = __builtin_amdgcn_s_memrealtime(); } while (0)
#else
#define SCAN_TSP ((unsigned long long*)nullptr)
#define STAMP(k) do { } while (0)
#endif
#define SEAM(k) do { if (hi > (k) + 1) { if ((k) == 0 || MK_N_LAUNCHES != 1) cg::this_grid().sync(); else grid_bar((unsigned*)(ws + WS_BAR), (++nbar) * (unsigned)G); } STAMP(k); } while (0)
    typedef pg8::StaticOrder SO;
    unsigned nbar = 0;
    if (bid == 0) for (int i = threadIdx.x; i < 3 * 64 * 64; i += NTHREADS) ((unsigned*)(ws + WS_CNT))[i] = 0u;
    if (bid == 0 && threadIdx.x == 0) __hip_atomic_store((unsigned*)(ws + WS_BAR), 0u, __ATOMIC_RELAXED, __HIP_MEMORY_SCOPE_AGENT);
    STAMP(-1);
    if (IN(0)) {
        PHASE_VARS
        convert_ffn(a.in[3], a.in[4], a.in[5], ws, scr, 0, 3 * IT_FF, gw, NGW, lane);
        convert_rest(a, scr, gw, NGW, lane);
        cvt_rows(x, XB, (size_t)M * D, gtid, gthreads);
        cvt_rows(a.in[1], (bf16*)(ws + WS_PB), (size_t)M * 256, gtid, gthreads);
        if (gtid < LW) ((float*)(ws + WS_SP))[gtid] = -8.0f * log1pf(expf(-a.in[15][gtid]));
        __syncthreads(); SEAM(0);
    }
    if (IN(1)) {
        PHASE_VARS
        pg8::Gemm g{XB, (const bf16*)(ws + WS_WFGU), M, 2 * FF, D, D, 0, 0}; SO S; S.init(M, 2 * FF, G, bid);
        pg8::EpiSwiglu E{HB, FF};
        pg8::gemm_phase<pg8::EpiSwiglu, SO, true, true>(lds, g, S, E);
        SEAM(1);
    }
    if (IN(2)) {
        PHASE_VARS
        pg8::Gemm g{HB, (const bf16*)(ws + WS_WFD), M, D, FF, FF, 0, 2}; SO S; S.init(M, D, G, bid);
        pg8::EpiResLn<false> E{x, nullptr, out, XB, D, ALPHA, 0.5f, a.in[6], a.in[7], (unsigned long long*)(ws + WS_SLOT), (unsigned*)(ws + WS_CNT), lds + 131072};
        pg8::gemm_phase<pg8::EpiResLn<false>, SO, false, true>(lds, g, S, E);
        SEAM(2);
    }
    if (IN(4)) {
        PHASE_VARS
        pg8::Gemm g{XB, (const bf16*)(ws + WS_WIN), M, NIN, D, D, 0, 0}; SO S; S.init(M, NIN, G, bid);
        pg8::EpiInProj E{HB, (const int*)a.in[2]};
        pg8::gemm_phase<pg8::EpiInProj, SO, true, true>(lds, g, S, E);
        if (5 * G + bid >= (M / 256) * (NIN / 256)) { __syncthreads(); const int first = (M / 256) * (NIN / 256) - 5 * G; convert_ffn(a.in[19], a.in[20], a.in[21], ws, scr, 0, W2_EARLY, (bid - first) * NWAVES + wave, (G - first) * NWAVES, lane, true); __syncthreads(); }
        SEAM(4);
    }
    if (IN(5)) {
        PHASE_VARS
        conv_rows(HB, a.in[9], a.in[10], XC, gtid, gthreads);
        convert_ffn(a.in[19], a.in[20], a.in[21], ws, scr, W2_EARLY, 3 * IT_FF, gw, NGW, lane, true);
        __syncthreads();
        SEAM(5);
    }
    if (IN(6)) {
        PHASE_VARS
        pg8::Gemm g{XC, (const bf16*)(ws + WS_WRG), M, 3072, 256, LW, 256, 0}; SO S; S.init(M, 3072, G, bid);
        pg8::EpiLru E{XC, LA, UU, a.in[12], a.in[14], (const float*)(ws + WS_SP)};
        pg8::gemm_phase<pg8::EpiLru, SO, true, true>(lds, g, S, E);
        __syncthreads(); STAMP(19);
        attn_mfma(HB, LSE, lds, gw, NGW, wave, lane); __syncthreads(); STAMP(21);
        SEAM(6);
    }
    if (IN(7)) {
        PHASE_VARS
        __syncthreads();
        scan_items(LA, UU, HB + SEC_YG, HB + SEC_K, (LAS float*)lds, G, bid, tid, SCAN_TSP);
        merge_rows(HB, LSE, HB + SEC_K, gtid, gthreads);
        SEAM(7);
    }
    if (IN(8)) {
        PHASE_VARS
        pg8::Gemm g{HB + SEC_K, (const bf16*)(ws + WS_WOUT), M, D, D, D, 0, 1}; SO S; S.init(M, D, G, bid);
        pg8::EpiResLn<true> E{nullptr, XB, out, XB, D, ALPHA, 1.0f, a.in[17], a.in[18], (unsigned long long*)(ws + WS_SLOT + 524288), (unsigned*)(ws + WS_CNT) + 4096, lds + 131072};
        pg8::gemm_phase<pg8::EpiResLn<true>, SO, false, true>(lds, g, S, E);
        SEAM(8);
    }
    if (IN(10)) {
        PHASE_VARS
        pg8::Gemm g{XB, (const bf16*)(ws + WS_WFGU), M, 2 * FF, D, D, 0, 0}; SO S; S.init(M, 2 * FF, G, bid);
        pg8::EpiSwiglu E{HB, FF};
        pg8::gemm_phase<pg8::EpiSwiglu, SO, true, true>(lds, g, S, E);
        SEAM(10);
    }
    if (IN(11)) {
        PHASE_VARS
        pg8::Gemm g{HB, (const bf16*)(ws + WS_WFD), M, D, FF, FF, 0, 2}; SO S; S.init(M, D, G, bid);
        pg8::EpiResLn<true> E{nullptr, XB, out, XB, D, ALPHA, 0.5f, a.in[22], a.in[23], (unsigned long long*)(ws + WS_SLOT + 2 * 524288), (unsigned*)(ws + WS_CNT) + 2 * 4096, lds + 131072};
        pg8::gemm_phase<pg8::EpiResLn<true>, SO, false, true>(lds, g, S, E);
        SEAM(11);
    }
    if (IN(13)) {
        PHASE_VARS
        { pg8::Gemm g{(const bf16*)(ws + WS_PB), (const bf16*)(ws + WS_WPP), M, D, 256, 256, 0, 0}; SO S; S.init(M, D, G, bid);
          pg8::EpiBf16 E{HB, D};
          pg8::gemm_phase<pg8::EpiBf16, SO, true, true>(lds, g, S, E); __syncthreads(); __builtin_amdgcn_fence(__ATOMIC_ACQUIRE, "agent"); __syncthreads(); }
        pg8::Gemm g{XB, (const bf16*)(ws + WS_WPG), M, D, D, D, 0, 0}; SO S; S.init(M, D, G, bid);
        pg8::EpiPle E{XB, out, HB, D};
        pg8::gemm_phase<pg8::EpiPle, SO, true, true>(lds, g, S, E);
    }
#ifdef PROBE_K
    cg::this_grid().sync();
    if (bid == 0) { const unsigned long long* ts = (const unsigned long long*)(ws + WS_TS); const int n = (int)((ts[PROBE_K + 1] - ts[PROBE_K0]) / 100ull);
        for (int i = threadIdx.x; i < n; i += NTHREADS) out[(size_t)i * 4099 + 7] += 0.0625f; }
#endif
#undef IN
#undef SEAM
}

extern "C" void kernel_launch(void* const* d_in, const int* in_sizes, int n_in, void* d_out, int out_size, void* d_ws, size_t ws_size, hipStream_t stream) {
    static int grid = 0;
    if (grid == 0) {
        if (n_in != 26 || out_size != M * D || ws_size < WS_END) { fprintf(stderr, "kernel_launch: unexpected problem (n_in %d, out %d, ws %zu)\n", n_in, out_size, ws_size); grid = -1; return; }
        int dev = 0, cus = 0, per_cu = 0;
        (void)hipGetDevice(&dev); (void)hipDeviceGetAttribute(&cus, hipDeviceAttributeMultiprocessorCount, dev);
        if (hipFuncSetAttribute((const void*)fwd_kernel, hipFuncAttributeMaxDynamicSharedMemorySize, LDS_BYTES) != hipSuccess) { fprintf(stderr, "kernel_launch: hipFuncSetAttribute failed\n"); grid = -1; return; }
        if (hipOccupancyMaxActiveBlocksPerMultiprocessor(&per_cu, (const void*)fwd_kernel, NTHREADS, LDS_BYTES) != hipSuccess || per_cu < 1) { fprintf(stderr, "kernel_launch: occupancy query says %d\n", per_cu); per_cu = 1; }
        (void)hipGetLastError();
        grid = cus * 1;
        if (grid != 256) { fprintf(stderr, "kernel_launch: built for a 256-CU device (fused LayerNorm epilogues need 256 workgroups), got %d\n", grid); grid = -1; return; }
    }
    if (grid < 0) return;
    Args a{};
    for (int i = 0; i < 26; ++i) a.in[i] = (const float*)d_in[i];
    a.out = (float*)d_out; a.ws = (unsigned char*)d_ws;
#if MK_N_LAUNCHES == 1
    a.ph_lo = 0; a.ph_hi = NPHASES;
    void* args[] = {&a};
    hipError_t e = hipLaunchCooperativeKernel((const void*)fwd_kernel, dim3(grid), dim3(NTHREADS), args, LDS_BYTES, stream);
    if (e != hipSuccess) fprintf(stderr, "cooperative launch failed: %s (grid %d)\n", hipGetErrorString(e), grid);
#else
    for (int p = 0; p < NPHASES; ++p) { a.ph_lo = p; a.ph_hi = p + 1; hipLaunchKernelGGL(fwd_kernel, dim3(grid), dim3(NTHREADS), LDS_BYTES, stream, a); }
#endif
}
```

```cpp
#include <hip/hip_runtime.h>
#include <hip/hip_cooperative_groups.h>
#include <cstdio>
#include <cstdint>
#include <type_traits>
namespace cg = cooperative_groups;
namespace pg8 {
#define PG8_LAS __attribute__((address_space(3)))
typedef unsigned short bf16_t;
typedef short bf16x8 __attribute__((ext_vector_type(8)));
typedef float f32x4 __attribute__((ext_vector_type(4)));
typedef unsigned u32x4 __attribute__((ext_vector_type(4)));
constexpr int BM = 256, BK = 64, HALF = 128, HTB = HALF * BK * 2  , STAGE_BYTES = 8 * HTB, NXCD = 8, WGM = 8;

__host__ __device__ __forceinline__ int lds_byte(int r, int c) { const int st = (r >> 4) * 2 + (c >> 5), rr = r & 15, cc = c & 31, ob = rr * 64 + cc * 2; return st * 1024 + (ob ^ (((ob >> 9) & 1) << 5)); }
__host__ __device__ __forceinline__ void stage_rc(int b, int& R, int& C) { const int st = b / 1024, sb = b % 1024, swz = sb ^ (((sb >> 9) & 1) << 5); R = (st >> 1) * 16 + swz / 64; C = (st & 1) * 32 + (swz % 64) / 2; }
__host__ __device__ __forceinline__ int perm32(int rho) { const int n = rho >> 4, i = rho & 15; return 8 * (i >> 2) + 4 * n + (i & 3); }

struct Unit { int pm, pn; };
struct Gemm { const bf16_t* A; const bf16_t* Bt; int M, N, K, lda, apn2, ablk; };

struct StaticOrder {
    int nM, nN, nwg, G, c;
    __host__ __device__ void init(int M, int N, int G_, int c_) { nM = M / BM; nN = N / BM; nwg = nM * nN; G = G_; c = c_; }
    __host__ __device__ bool next(int i, Unit& u) const {
        const long L = (long)i * G + c; if (L >= nwg) return false;
        int wgid = (int)L; { const int q = nwg / NXCD, r = nwg % NXCD, xcd = wgid % NXCD, off = wgid / NXCD; wgid = (xcd < r ? xcd * (q + 1) : r * (q + 1) + (xcd - r) * q) + off; }
        const int nig = WGM * nN, gid = wgid / nig, fm = gid * WGM, gsz = (nM - fm) < WGM ? (nM - fm) : WGM;
        u.pm = fm + ((wgid % nig) % gsz); u.pn = (wgid % nig) / gsz; return true;
    }
    __device__ __forceinline__ void a_ready(const Unit&) const {}
    __device__ __forceinline__ void done(const Unit&) const {}
};

__device__ __forceinline__ unsigned cvt_pk_bf16(float lo, float hi) { unsigned r; asm volatile("v_cvt_pk_bf16_f32 %0, %1, %2" : "=v"(r) : "v"(lo), "v"(hi)); return r; }
typedef float f32x2 __attribute__((ext_vector_type(2)));

__device__ __forceinline__ float sigmoid_f(float v) { return __builtin_amdgcn_rcpf(1.0f + __builtin_amdgcn_exp2f(-1.4426950408889634f * v)); }
struct EpiBf16 {
    static constexpr bool PERM = true, AFTER_DRAIN = false;
    bf16_t* O; int ldc;
    __device__ __forceinline__ void operator()(const f32x4 (&acc)[2][2][4][2], const Unit& u, int wr, int wc, int fr, int fq) const {
        const int row0 = u.pm * BM + wr * 64 + fr, col0 = u.pn * BM + wc * 32 + 8 * fq;
#pragma unroll
        for (int ai = 0; ai < 2; ++ai)
#pragma unroll
            for (int m = 0; m < 4; ++m) { bf16_t* rowp = O + (size_t)(row0 + ai * HALF + m * 16) * ldc + col0;
#pragma unroll
                for (int bj = 0; bj < 2; ++bj) { const f32x4 v0 = acc[ai][bj][m][0], v1 = acc[ai][bj][m][1];
                    u32x4 w; w.x = cvt_pk_bf16(v0[0], v0[1]); w.y = cvt_pk_bf16(v0[2], v0[3]); w.z = cvt_pk_bf16(v1[0], v1[1]); w.w = cvt_pk_bf16(v1[2], v1[3]);
                    *(u32x4*)(rowp + bj * HALF) = w; } }
    }
};
struct EpiSwiglu {
    static constexpr bool PERM = true, AFTER_DRAIN = false;
    bf16_t* O; int ldc;
    __device__ __forceinline__ void operator()(const f32x4 (&acc)[2][2][4][2], const Unit& u, int wr, int wc, int fr, int fq) const {
        const int row0 = u.pm * BM + wr * 64 + fr, col0 = u.pn * HALF + wc * 32 + 8 * fq;
#pragma unroll
        for (int ai = 0; ai < 2; ++ai)
#pragma unroll
            for (int m = 0; m < 4; ++m) { bf16_t* rowp = O + ((size_t)(col0 >> 6) * 16384 + (size_t)(row0 + ai * HALF + m * 16)) * 64 + (col0 & 63);
                float h[8];
#pragma unroll
                for (int n = 0; n < 2; ++n)
#pragma unroll
                    for (int j = 0; j < 4; ++j) { const float g = acc[ai][0][m][n][j], up = acc[ai][1][m][n][j]; h[4 * n + j] = g * sigmoid_f(g) * up; }
                u32x4 w; w.x = cvt_pk_bf16(h[0], h[1]); w.y = cvt_pk_bf16(h[2], h[3]); w.z = cvt_pk_bf16(h[4], h[5]); w.w = cvt_pk_bf16(h[6], h[7]);
                *(u32x4*)rowp = w; }
    }
};
struct EpiResF32 {
    static constexpr bool PERM = false, AFTER_DRAIN = false;
    const float* base; float* out; int ldc; float alpha, s;
    __device__ __forceinline__ void operator()(const f32x4 (&acc)[2][2][4][2], const Unit& u, int wr, int wc, int fr, int fq) const {
        const int row0 = u.pm * BM + wr * 64 + fr, col0 = u.pn * BM + wc * 32 + 4 * fq;
#pragma unroll
        for (int ai = 0; ai < 2; ++ai)
#pragma unroll
            for (int m = 0; m < 4; ++m) { const size_t off = (size_t)(row0 + ai * HALF + m * 16) * ldc + col0;
#pragma unroll
                for (int bj = 0; bj < 2; ++bj)
#pragma unroll
                    for (int n = 0; n < 2; ++n) { f32x4 v = acc[ai][bj][m][n] * s; if (base) v += *(const f32x4*)(base + off + bj * HALF + n * 16) * alpha; *(f32x4*)(out + off + bj * HALF + n * 16) = v; } }
    }
};
template <bool BB> struct EpiResLn {
    static constexpr bool PERM = false, AFTER_DRAIN = true;
    const float* base; const bf16_t* baseb; float* zs; bf16_t* xb; int ldc; float alpha, s; const float* g; const float* b;
    unsigned long long* slots; unsigned* cnt; PG8_LAS unsigned char* xl;
    typedef float f32x2v __attribute__((ext_vector_type(2))); typedef unsigned u32x2v __attribute__((ext_vector_type(2)));
    typedef typename std::conditional<BB, u32x2v, f32x4>::type bvec;
    __device__ __forceinline__ bvec ldb(size_t o) const { if constexpr (BB) return *(const u32x2v*)(baseb + o); else return *(const f32x4*)(base + o); }
    static __device__ __forceinline__ f32x4 cvb(const bvec& v) { if constexpr (BB) return (f32x4){__uint_as_float(v.x << 16), __uint_as_float(v.x & 0xffff0000u), __uint_as_float(v.y << 16), __uint_as_float(v.y & 0xffff0000u)}; else return v; }
    __device__ __forceinline__ void first(const f32x4 (&acc)[2][2][4][2], const Unit& u, int wr, int wc, int fr, int fq) const {
        PG8_LAS f32x2v* SAp = (PG8_LAS f32x2v*)xl;
        const int row0 = u.pm * BM + wr * 64 + fr, col0 = u.pn * BM + wc * 32 + 4 * fq;
#pragma unroll
        for (int ai = 0; ai < 2; ++ai) { bvec bv[4][4];
#pragma unroll
            for (int m = 0; m < 4; ++m)
#pragma unroll
                for (int q = 0; q < 4; ++q) bv[m][q] = ldb((size_t)(row0 + ai * HALF + m * 16) * ldc + col0 + (q >> 1) * HALF + (q & 1) * 16);
#pragma unroll
            for (int m = 0; m < 4; ++m) { const size_t off = (size_t)(row0 + ai * HALF + m * 16) * ldc + col0; float s1 = 0.f, s2 = 0.f;
#pragma unroll
                for (int q = 0; q < 4; ++q) { const f32x4 v = acc[ai][q >> 1][m][q & 1] * s + cvb(bv[m][q]) * alpha; *(f32x4*)(zs + off + (q >> 1) * HALF + (q & 1) * 16) = v;
                    s1 += (v[0] + v[1]) + (v[2] + v[3]); s2 += (v[0] * v[0] + v[1] * v[1]) + (v[2] * v[2] + v[3] * v[3]); }
                s1 += __shfl_xor(s1, 16); s1 += __shfl_xor(s1, 32); s2 += __shfl_xor(s2, 16); s2 += __shfl_xor(s2, 32);
                if (fq == 0) SAp[(ai * HALF + wr * 64 + m * 16 + fr) * 4 + wc] = (f32x2v){s1, s2}; }
            asm volatile("" ::: "memory"); }
    }
    __device__ __forceinline__ void fused(f32x4 (&acc)[2][2][4][2], const Unit& u, int wr, int wc, int fr, int fq, PG8_LAS unsigned char* lds, int wid, int lane) const {
        PG8_LAS f32x2v* P = (PG8_LAS f32x2v*)lds;
        PG8_LAS f32x2v* SAp = (PG8_LAS f32x2v*)xl;
        PG8_LAS f32x2v* St = (PG8_LAS f32x2v*)(lds + 8192);
        const int row0 = u.pm * BM + wr * 64 + fr, col0 = u.pn * BM + wc * 32 + 4 * fq;
#pragma unroll
        for (int ai = 0; ai < 2; ++ai) { bvec bv[4][4];
#pragma unroll
            for (int m = 0; m < 4; ++m)
#pragma unroll
                for (int q = 0; q < 4; ++q) bv[m][q] = ldb((size_t)(row0 + ai * HALF + m * 16) * ldc + col0 + (q >> 1) * HALF + (q & 1) * 16);
#pragma unroll
            for (int m = 0; m < 4; ++m) { float s1 = 0.f, s2 = 0.f;
#pragma unroll
                for (int q = 0; q < 4; ++q) { const f32x4 v = acc[ai][q >> 1][m][q & 1] * s + cvb(bv[m][q]) * alpha; acc[ai][q >> 1][m][q & 1] = v;
                    s1 += (v[0] + v[1]) + (v[2] + v[3]); s2 += (v[0] * v[0] + v[1] * v[1]) + (v[2] * v[2] + v[3] * v[3]); }
                s1 += __shfl_xor(s1, 16); s1 += __shfl_xor(s1, 32); s2 += __shfl_xor(s2, 16); s2 += __shfl_xor(s2, 32);
                if (fq == 0) P[(ai * HALF + wr * 64 + m * 16 + fr) * 4 + wc] = (f32x2v){s1, s2}; }
            asm volatile("" ::: "memory"); }
        asm volatile("s_waitcnt lgkmcnt(0)" ::: "memory"); __builtin_amdgcn_s_barrier(); asm volatile("" ::: "memory");
        const int row = wid * 32 + (lane & 31);
        if (lane < 32) { float su = 0.f, sq = 0.f;
#pragma unroll
            for (int k = 0; k < 4; ++k) { const f32x2v a = P[row * 4 + k], c = SAp[row * 4 + k]; su += a.x + c.x; sq += a.y + c.y; }
            __hip_atomic_store(slots + ((size_t)(u.pm * BM + row) * 4 + (u.pn & 3)), ((unsigned long long)__float_as_uint(sq) << 32) | __float_as_uint(su), __ATOMIC_RELAXED, __HIP_MEMORY_SCOPE_AGENT); }
        asm volatile("s_waitcnt vmcnt(0)" ::: "memory");
        if (lane == 0) __hip_atomic_fetch_add(cnt + 64 * u.pm, 1u, __ATOMIC_RELAXED, __HIP_MEMORY_SCOPE_AGENT);
        if (wid == 0) { unsigned spins = 0;
            while ((unsigned)__builtin_amdgcn_readfirstlane(__hip_atomic_load(cnt + 64 * u.pm, __ATOMIC_RELAXED, __HIP_MEMORY_SCOPE_AGENT)) < 32u && ++spins < (1u << 22)) __builtin_amdgcn_s_sleep(2);
            __builtin_amdgcn_fence(__ATOMIC_ACQUIRE, "agent"); }
        asm volatile("s_waitcnt vmcnt(0) lgkmcnt(0)" ::: "memory"); __builtin_amdgcn_s_barrier(); asm volatile("" ::: "memory");
        if (lane < 32) { float su = 0.f, sq = 0.f; const unsigned long long* sl = slots + (size_t)(u.pm * BM + row) * 4;
#pragma unroll
            for (int k = 0; k < 4; ++k) { const unsigned long long w = __hip_atomic_load(sl + k, __ATOMIC_RELAXED, __HIP_MEMORY_SCOPE_AGENT); su += __uint_as_float((unsigned)w); sq += __uint_as_float((unsigned)(w >> 32)); }
            const float mean = su * (1.0f / 2048.0f), var = fmaxf(sq * (1.0f / 2048.0f) - mean * mean, 0.f);
            St[row] = (f32x2v){mean, 1.0f / sqrtf(var + 1e-5f)}; }
        asm volatile("s_waitcnt lgkmcnt(0)" ::: "memory"); __builtin_amdgcn_s_barrier(); asm volatile("" ::: "memory");
        { f32x4 gg[4], bb[4];
#pragma unroll
          for (int q = 0; q < 4; ++q) { gg[q] = *(const f32x4*)(g + col0 + (q >> 1) * HALF + (q & 1) * 16); bb[q] = *(const f32x4*)(b + col0 + (q >> 1) * HALF + (q & 1) * 16); }
#pragma unroll
          for (int ai = 0; ai < 2; ++ai)
#pragma unroll
            for (int m = 0; m < 4; ++m) { const int r = ai * HALF + wr * 64 + m * 16 + fr; const f32x2v sr = St[r]; const size_t off = (size_t)(u.pm * BM + r) * ldc + col0;
#pragma unroll
                for (int q = 0; q < 4; ++q) { const size_t o2 = off + (q >> 1) * HALF + (q & 1) * 16; const f32x4 y = (acc[ai][q >> 1][m][q & 1] - sr.x) * sr.y * gg[q] + bb[q];
                    *(u32x2v*)(xb + o2) = (u32x2v){cvt_pk_bf16(y[0], y[1]), cvt_pk_bf16(y[2], y[3])}; } } }
        asm volatile("" ::: "memory");
        { const int colA = col0 - 1024; f32x4 gg[4], bb[4];
#pragma unroll
          for (int q = 0; q < 4; ++q) { gg[q] = *(const f32x4*)(g + colA + (q >> 1) * HALF + (q & 1) * 16); bb[q] = *(const f32x4*)(b + colA + (q >> 1) * HALF + (q & 1) * 16); }
#pragma unroll
          for (int ai = 0; ai < 2; ++ai) { f32x4 zv[4][4];
#pragma unroll
            for (int m = 0; m < 4; ++m)
#pragma unroll
                for (int q = 0; q < 4; ++q) zv[m][q] = *(const f32x4*)(zs + (size_t)(u.pm * BM + ai * HALF + wr * 64 + m * 16 + fr) * ldc + colA + (q >> 1) * HALF + (q & 1) * 16);
#pragma unroll
            for (int m = 0; m < 4; ++m) { const int r = ai * HALF + wr * 64 + m * 16 + fr; const f32x2v sr = St[r]; const size_t off = (size_t)(u.pm * BM + r) * ldc + colA;
#pragma unroll
                for (int q = 0; q < 4; ++q) { const size_t o2 = off + (q >> 1) * HALF + (q & 1) * 16; const f32x4 y = (zv[m][q] - sr.x) * sr.y * gg[q] + bb[q];
                    *(u32x2v*)(xb + o2) = (u32x2v){cvt_pk_bf16(y[0], y[1]), cvt_pk_bf16(y[2], y[3])}; } }
            asm volatile("" ::: "memory"); } }
    }
};
struct EpiPle {
    static constexpr bool PERM = false, AFTER_DRAIN = false;
    const bf16_t* x3; float* xo; const bf16_t* pp; int ldc;
    typedef unsigned u32x2p __attribute__((ext_vector_type(2)));
    __device__ __forceinline__ void operator()(const f32x4 (&acc)[2][2][4][2], const Unit& u, int wr, int wc, int fr, int fq) const {
        const int row0 = u.pm * BM + wr * 64 + fr, col0 = u.pn * BM + wc * 32 + 4 * fq;
#pragma unroll
        for (int ai = 0; ai < 2; ++ai)
#pragma unroll
            for (int mp = 0; mp < 2; ++mp) { u32x2p xv[2][4], pv[2][4];
#pragma unroll
                for (int mm = 0; mm < 2; ++mm)
#pragma unroll
                    for (int q = 0; q < 4; ++q) { const size_t o2 = (size_t)(row0 + ai * HALF + (2 * mp + mm) * 16) * ldc + col0 + (q >> 1) * HALF + (q & 1) * 16; xv[mm][q] = *(const u32x2p*)(x3 + o2); pv[mm][q] = *(const u32x2p*)(pp + o2); }
#pragma unroll
                for (int mm = 0; mm < 2; ++mm)
#pragma unroll
                    for (int q = 0; q < 4; ++q) { const int m = 2 * mp + mm; const size_t o2 = (size_t)(row0 + ai * HALF + m * 16) * ldc + col0 + (q >> 1) * HALF + (q & 1) * 16;
                        const f32x4 a = acc[ai][q >> 1][m][q & 1]; const u32x2p xw = xv[mm][q], pw = pv[mm][q];
                        const f32x4 p = {__uint_as_float(pw.x << 16), __uint_as_float(pw.x & 0xffff0000u), __uint_as_float(pw.y << 16), __uint_as_float(pw.y & 0xffff0000u)};
                        f32x4 r; r[0] = __uint_as_float(xw.x << 16) + sigmoid_f(a[0]) * p[0]; r[1] = __uint_as_float(xw.x & 0xffff0000u) + sigmoid_f(a[1]) * p[1];
                        r[2] = __uint_as_float(xw.y << 16) + sigmoid_f(a[2]) * p[2]; r[3] = __uint_as_float(xw.y & 0xffff0000u) + sigmoid_f(a[3]) * p[3];
                        *(f32x4*)(xo + o2) = r; }
                asm volatile("" ::: "memory"); }
    }
};
__device__ __forceinline__ float gelu_tanh_f(float x) { const float y = 0.7978845608028654f * (x + 0.044715f * x * x * x); const float t = 1.0f - 2.0f * __builtin_amdgcn_rcpf(1.0f + __builtin_amdgcn_exp2f(2.8853900817779268f * y)); return 0.5f * x * (1.0f + t); }
struct EpiInProj {
    static constexpr bool PERM = true, AFTER_DRAIN = false;
    bf16_t* Hb; const int* pos;
    __device__ __forceinline__ void operator()(const f32x4 (&acc)[2][2][4][2], const Unit& u, int wr, int wc, int fr, int fq) const {
        constexpr float INVF[16] = {1.000000000e+00f, 4.403665960e-01f, 1.939227432e-01f, 8.539710194e-02f, 3.760603070e-02f, 1.656043902e-02f, 7.292664610e-03f, 3.211445874e-03f,
                                    1.414213562e-03f, 6.227723788e-04f, 2.742481884e-04f, 1.207697351e-04f, 5.318296098e-05f, 2.341999971e-05f, 1.031338616e-05f, 4.541670478e-06f};
        const int pn = u.pn, row0 = u.pm * BM + wr * 64 + fr, cw = wc * 32 + 8 * fq;
        if (pn >= 16) {
#pragma unroll
            for (int ai = 0; ai < 2; ++ai)
#pragma unroll
                for (int m = 0; m < 4; ++m) { const int row = row0 + ai * HALF + m * 16;
#pragma unroll
                    for (int bj = 0; bj < 2; ++bj) { const int ch0 = (pn - 16) * 256 + bj * HALF + cw;
                        bf16_t* p = Hb + (size_t)16384 * 4096 + ((size_t)((row >> 13) * 96 + (ch0 >> 4)) * 8192 + (row & 8191)) * 16 + (ch0 & 15);
                        float h[8];
#pragma unroll
                        for (int e = 0; e < 8; ++e) h[e] = gelu_tanh_f(acc[ai][bj][m][e >> 2][e & 3]);
                        u32x4 w; w.x = cvt_pk_bf16(h[0], h[1]); w.y = cvt_pk_bf16(h[2], h[3]); w.z = cvt_pk_bf16(h[4], h[5]); w.w = cvt_pk_bf16(h[6], h[7]); *(u32x4*)p = w; } }
            return;
        }
        bf16_t* base; int ld, c0;
        if (pn < 6) { base = Hb; ld = 1536; c0 = pn * 256; }
        else if (pn < 8) { base = Hb + (size_t)16384 * 1536; ld = 512; c0 = (pn - 6) * 256; }
        else if (pn < 10) { base = Hb + (size_t)16384 * 2048; ld = 512; c0 = (pn - 8) * 256; }
        else { base = Hb + (size_t)16384 * 2560; ld = 1536; c0 = (pn - 10) * 256; }
        const bool rot = (pn < 8) && (wc == 0);
        const float sgn = (fq < 2) ? -1.0f : 1.0f;
#pragma unroll
        for (int ai = 0; ai < 2; ++ai)
#pragma unroll
            for (int m = 0; m < 4; ++m) { const int row = row0 + ai * HALF + m * 16; bf16_t* rowp = base + (size_t)row * ld + c0 + cw;
                float cs[8], sn[8];
                if (rot) { const float ps = (float)pos[row];
#pragma unroll
                    for (int e = 0; e < 8; ++e) { const float ang = ps * ((fq & 1) ? INVF[8 + e] : INVF[e]); const float kq = rintf(ang * 0.15915494309189535f);
                        float r1 = fmaf(-kq, 6.28125f, ang); r1 = fmaf(-kq, 1.9353071795864769e-3f, r1); cs[e] = __cosf(r1); sn[e] = __sinf(r1) * sgn; } }
#pragma unroll
                for (int bj = 0; bj < 2; ++bj) { float v[8];
#pragma unroll
                    for (int e = 0; e < 8; ++e) v[e] = acc[ai][bj][m][e >> 2][e & 3];
                    if (rot) {
#pragma unroll
                        for (int e = 0; e < 8; ++e) { const float pt = __shfl_xor(v[e], 32); v[e] = v[e] * cs[e] + pt * sn[e]; } }
                    u32x4 w; w.x = cvt_pk_bf16(v[0], v[1]); w.y = cvt_pk_bf16(v[2], v[3]); w.z = cvt_pk_bf16(v[4], v[5]); w.w = cvt_pk_bf16(v[6], v[7]);
                    *(u32x4*)(rowp + bj * HALF) = w; } }
    }
};
struct EpiLru {
    static constexpr bool PERM = true, AFTER_DRAIN = false;
    const bf16_t* xc; bf16_t* la; bf16_t* uo; const float* br; const float* bi; const float* sp;
    __device__ __forceinline__ void operator()(const f32x4 (&acc)[2][2][4][2], const Unit& u, int wr, int wc, int fr, int fq) const {
        const int row0 = u.pm * BM + wr * 64 + fr, ch0 = u.pn * HALF + wc * 32 + 8 * fq;
#pragma unroll
        for (int ai = 0; ai < 2; ++ai)
#pragma unroll
            for (int m = 0; m < 4; ++m) { const int row = row0 + ai * HALF + m * 16; const size_t off = (size_t)row * 1536 + ch0;
                const size_t ob = ((size_t)((row >> 13) * 96 + (ch0 >> 4)) * 8192 + (row & 8191)) * 16 + (ch0 & 15);
                const u32x4 xv = *(const u32x4*)(xc + off); unsigned lw[4], uw[4];
#pragma unroll
                for (int n = 0; n < 2; ++n) { const f32x4 brv = *(const f32x4*)(br + ch0 + 4 * n), biv = *(const f32x4*)(bi + ch0 + 4 * n), spv = *(const f32x4*)(sp + ch0 + 4 * n); float lv[4], uv[4];
#pragma unroll
                    for (int j = 0; j < 4; ++j) { const unsigned xw = xv[2 * n + (j >> 1)]; const float x = __uint_as_float((j & 1) ? (xw & 0xffff0000u) : (xw << 16));
                        const float r = sigmoid_f(acc[ai][0][m][n][j] + brv[j]), ig = sigmoid_f(acc[ai][1][m][n][j] + biv[j]);
                        const float l = spv[j] * r, a = __expf(l); lv[j] = 1.0f - a; uv[j] = __builtin_amdgcn_sqrtf(fmaxf(1.0f - a * a, 0.f)) * (ig * x); }
                    lw[2 * n] = cvt_pk_bf16(lv[0], lv[1]); lw[2 * n + 1] = cvt_pk_bf16(lv[2], lv[3]); uw[2 * n] = cvt_pk_bf16(uv[0], uv[1]); uw[2 * n + 1] = cvt_pk_bf16(uv[2], uv[3]); }
                *(u32x4*)(la + ob) = (u32x4){lw[0], lw[1], lw[2], lw[3]}; *(u32x4*)(uo + ob) = (u32x4){uw[0], uw[1], uw[2], uw[3]};
                asm volatile("" ::: "memory"); }
    }
};

template <class Epi, class Sched, bool ALIGN_EPI = false, bool SP2 = false>
__device__ __forceinline__ void gemm_phase(PG8_LAS unsigned char* lds, const Gemm g, const Sched& S, const Epi& E) {
    int tid_ = threadIdx.x; asm volatile("" : "+v"(tid_));
    const int tid = tid_, wid = __builtin_amdgcn_readfirstlane(tid >> 6), lane = tid & 63, wr = wid >> 2, wc = wid & 3, fr = lane & 15, fq = lane >> 4;
    const int K = g.K, nt = K / BK;
    unsigned voffA[2], voffB[2];
#pragma unroll
    for (int i = 0; i < 2; ++i) { int R, C; stage_rc(tid * 16 + i * 8192, R, C); const int Rb = Epi::PERM ? ((R & ~31) + perm32(R & 31)) : R;
        voffA[i] = g.ablk == 2 ? (unsigned)(R * 64 + C) * 2u : g.ablk ? (unsigned)((C >> 4) * (8192 * 16) + R * 16 + (C & 15)) * 2u : (unsigned)(R * g.lda + C) * 2u; voffB[i] = (unsigned)(Rb * K + C) * 2u; }
    const size_t kstepB = (size_t)(BK * 2), kstepA = g.ablk == 2 ? (size_t)g.M * 64 * 2 : g.ablk ? (size_t)4 * 8192 * 16 * 2 : (size_t)(BK * 2);
    const size_t hstepA = g.ablk == 2 ? (size_t)HALF * 64 * 2 : g.ablk ? (size_t)HALF * 16 * 2 : (size_t)HALF * g.lda * 2, hstepB = (size_t)HALF * K * 2;
    const size_t tstepA = 2 * hstepA, tstepB = 2 * hstepB;
    const unsigned ldsw = (unsigned)wid * 1024u;
    const int aoff = lds_byte(wr * 64 + fr, fq * 8), boff = lds_byte(wc * 32 + fr, fq * 8);
#define PG8_SA(b, h) (((b) * 2 + (h)) * HTB)
#define PG8_SB(b, h) ((4 + (b) * 2 + (h)) * HTB)
#define PG8_STAGE(bufoff, gbase, voff) do { _Pragma("unroll") for (int _i = 0; _i < 2; ++_i) \
        __builtin_amdgcn_global_load_lds((const unsigned*)((const char*)(gbase) + (voff)[_i]), (PG8_LAS unsigned*)(lds + (bufoff) + ldsw + _i * 8192), 16, 0, 0); } while (0)
#define PG8_LDA(dst, b, h) do { _Pragma("unroll") for (int m = 0; m < 4; ++m) _Pragma("unroll") for (int k = 0; k < 2; ++k) dst[m][k] = *(const PG8_LAS bf16x8*)(lds + PG8_SA(b, h) + aoff + m * 2048 + k * 1024); } while (0)
#define PG8_LDB(dst, b, h) do { _Pragma("unroll") for (int n = 0; n < 2; ++n) _Pragma("unroll") for (int k = 0; k < 2; ++k) dst[n][k] = *(const PG8_LAS bf16x8*)(lds + PG8_SB(b, h) + boff + n * 2048 + k * 1024); } while (0)
#define PG8_MMA(ai, bj, At, Bt) do { __builtin_amdgcn_s_setprio(1); _Pragma("unroll") for (int m = 0; m < 4; ++m) _Pragma("unroll") for (int n = 0; n < 2; ++n) _Pragma("unroll") for (int k = 0; k < 2; ++k) \
        acc[ai][bj][m][n] = __builtin_amdgcn_mfma_f32_16x16x32_bf16(Bt[n][k], At[m][k], acc[ai][bj][m][n], 0, 0, 0); __builtin_amdgcn_s_setprio(0); } while (0)
#define PG8_WAIT_V(n) asm volatile("s_waitcnt vmcnt(" #n ")" ::: "memory")
#define PG8_WAIT_L(n) asm volatile("s_waitcnt lgkmcnt(" #n ")" ::: "memory")
#define PG8_BAR __builtin_amdgcn_s_barrier()
#define PG8_SCHED __builtin_amdgcn_sched_barrier(0)
    Unit cur, nxt; int ui = 0;
    if (!S.next(0, cur)) return;
    f32x4 acc[2][2][4][2];
#pragma unroll
    for (int a = 0; a < 2; ++a)
#pragma unroll
        for (int b = 0; b < 2; ++b)
#pragma unroll
            for (int m = 0; m < 4; ++m)
#pragma unroll
                for (int n = 0; n < 2; ++n) acc[a][b][m][n] = (f32x4){0.f, 0.f, 0.f, 0.f};
    bf16x8 At[4][2], B0[2][2], B1[2][2];
    const char* cA = (const char*)g.A + (g.ablk == 2 ? (size_t)cur.pm * 256 * 64 * 2 : g.ablk ? ((size_t)(cur.pm >> 5) * 128 * 8192 * 16 + (size_t)(cur.pm & 31) * 256 * 16) * 2 : (size_t)cur.pm * tstepA + (size_t)(cur.pn >> 1) * g.apn2 * 2); const char* cB = (const char*)g.Bt + (size_t)cur.pn * tstepB;
    S.a_ready(cur);
    if constexpr (SP2) {
        PG8_STAGE(PG8_SB(0, 0), cB, voffB); PG8_STAGE(PG8_SB(0, 1), cB + hstepB, voffB); PG8_STAGE(PG8_SA(0, 0), cA, voffA); PG8_STAGE(PG8_SA(0, 1), cA + hstepA, voffA);
        if (wr == 1) PG8_BAR;
        PG8_WAIT_V(2); PG8_BAR;
        PG8_STAGE(PG8_SB(1, 0), cB + kstepB, voffB); PG8_STAGE(PG8_SA(1, 0), cA + kstepA, voffA); PG8_STAGE(PG8_SB(1, 1), cB + hstepB + kstepB, voffB);
        PG8_WAIT_V(6); PG8_BAR;
    } else {
        PG8_STAGE(PG8_SB(0, 0), cB, voffB); PG8_STAGE(PG8_SA(0, 0), cA, voffA); PG8_STAGE(PG8_SB(0, 1), cB + hstepB, voffB); PG8_STAGE(PG8_SA(0, 1), cA + hstepA, voffA);
        if (wr == 1) PG8_BAR;
        PG8_WAIT_V(4); PG8_BAR;
        PG8_STAGE(PG8_SB(1, 0), cB + kstepB, voffB); PG8_STAGE(PG8_SA(1, 0), cA + kstepA, voffA); PG8_STAGE(PG8_SB(1, 1), cB + hstepB + kstepB, voffB);
        PG8_WAIT_V(6); PG8_BAR;
    }
    for (;;) {
        const bool has_next = S.next(ui + 1, nxt);
        const char* nA = has_next ? (const char*)g.A + (g.ablk == 2 ? (size_t)nxt.pm * 256 * 64 * 2 : g.ablk ? ((size_t)(nxt.pm >> 5) * 128 * 8192 * 16 + (size_t)(nxt.pm & 31) * 256 * 16) * 2 : (size_t)nxt.pm * tstepA + (size_t)(nxt.pn >> 1) * g.apn2 * 2) : cA; const char* nB = has_next ? (const char*)g.Bt + (size_t)nxt.pn * tstepB : cB;
        for (int t = 0; t < nt; t += 2) {
            const bool last = (t == nt - 2);
            const char* a1 = cA + (size_t)(t + 1) * kstepA;
            const char* a2 = last ? nA : cA + (size_t)(t + 2) * kstepA; const char* b2 = last ? nB : cB + (size_t)(t + 2) * kstepB;
            const char* a3 = a2 + kstepA; const char* b3 = b2 + kstepB;
            if (last && has_next) S.a_ready(nxt);
            if constexpr (SP2) {
            PG8_LDB(B0, 0, 0); PG8_LDB(B1, 0, 1); PG8_SCHED; PG8_LDA(At, 0, 0); PG8_STAGE(PG8_SA(1, 1), a1 + hstepA, voffA);
            PG8_WAIT_V(8); PG8_WAIT_L(0); PG8_BAR; PG8_MMA(0, 0, At, B0); PG8_MMA(0, 1, At, B1); PG8_BAR; PG8_SCHED;
            PG8_LDA(At, 0, 1); PG8_STAGE(PG8_SB(0, 0), b2, voffB); PG8_STAGE(PG8_SB(0, 1), b2 + hstepB, voffB); PG8_STAGE(PG8_SA(0, 0), a2, voffA);
            PG8_WAIT_V(8); PG8_WAIT_L(0); PG8_BAR; PG8_MMA(1, 0, At, B0); PG8_MMA(1, 1, At, B1); PG8_BAR; PG8_SCHED;
            PG8_LDB(B0, 1, 0); PG8_LDB(B1, 1, 1); PG8_SCHED; PG8_LDA(At, 1, 0); PG8_STAGE(PG8_SA(0, 1), a2 + hstepA, voffA);
            PG8_WAIT_V(8); PG8_WAIT_L(0); PG8_BAR; PG8_MMA(0, 0, At, B0); PG8_MMA(0, 1, At, B1); PG8_BAR; PG8_SCHED;
            PG8_LDA(At, 1, 1); PG8_STAGE(PG8_SB(1, 0), b3, voffB); PG8_STAGE(PG8_SB(1, 1), b3 + hstepB, voffB); PG8_STAGE(PG8_SA(1, 0), a3, voffA);
            PG8_WAIT_V(8); PG8_WAIT_L(0); PG8_BAR; PG8_MMA(1, 0, At, B0); PG8_MMA(1, 1, At, B1); PG8_BAR; PG8_SCHED;
            } else {
            PG8_LDB(B0, 0, 0); PG8_SCHED; PG8_LDA(At, 0, 0); PG8_STAGE(PG8_SA(1, 1), a1 + hstepA, voffA);
            PG8_WAIT_L(8); PG8_BAR; PG8_WAIT_L(0); PG8_MMA(0, 0, At, B0); PG8_BAR; PG8_SCHED;
            PG8_LDB(B1, 0, 1); PG8_STAGE(PG8_SB(0, 0), b2, voffB);
            PG8_BAR; PG8_WAIT_L(0); PG8_MMA(0, 1, At, B1); PG8_BAR;
            PG8_LDA(At, 0, 1); PG8_STAGE(PG8_SA(0, 0), a2, voffA);
            PG8_BAR; PG8_WAIT_L(0); PG8_MMA(1, 0, At, B0); PG8_BAR; PG8_SCHED;
            PG8_STAGE(PG8_SB(0, 1), b2 + hstepB, voffB);
            PG8_WAIT_V(6); PG8_BAR; PG8_MMA(1, 1, At, B1); PG8_BAR;
            PG8_LDB(B0, 1, 0); PG8_SCHED; PG8_LDA(At, 1, 0); PG8_STAGE(PG8_SA(0, 1), a2 + hstepA, voffA);
            PG8_WAIT_L(8); PG8_BAR; PG8_WAIT_L(0); PG8_MMA(0, 0, At, B0); PG8_BAR; PG8_SCHED;
            PG8_LDB(B1, 1, 1); PG8_STAGE(PG8_SB(1, 0), b3, voffB);
            PG8_BAR; PG8_WAIT_L(0); PG8_MMA(0, 1, At, B1); PG8_BAR;
            PG8_LDA(At, 1, 1); PG8_STAGE(PG8_SA(1, 0), a3, voffA);
            PG8_BAR; PG8_WAIT_L(0); PG8_MMA(1, 0, At, B0); PG8_BAR; PG8_SCHED;
            PG8_STAGE(PG8_SB(1, 1), b3 + hstepB, voffB);
            PG8_WAIT_V(6); PG8_BAR; PG8_MMA(1, 1, At, B1); PG8_BAR;
            }
        }
        if constexpr (ALIGN_EPI) { if (wr == 0) PG8_BAR; }
        if constexpr (!Epi::AFTER_DRAIN) { E(acc, cur, wr, wc, fr, fq); S.done(cur); } else { if (has_next) E.first(acc, cur, wr, wc, fr, fq); }
        if (!has_next) break;
#pragma unroll
        for (int a = 0; a < 2; ++a)
#pragma unroll
            for (int b = 0; b < 2; ++b)
#pragma unroll
                for (int m = 0; m < 4; ++m)
#pragma unroll
                    for (int n = 0; n < 2; ++n) acc[a][b][m][n] = (f32x4){0.f, 0.f, 0.f, 0.f};
        cur = nxt; cA = nA; cB = nB; ++ui;
        if constexpr (ALIGN_EPI) { if (wr == 1) PG8_BAR; }
    }
    PG8_WAIT_V(0);
    if constexpr (!ALIGN_EPI) { if (wr == 0) PG8_BAR; }
    PG8_BAR;
    if constexpr (Epi::AFTER_DRAIN) { E.fused(acc, cur, wr, wc, fr, fq, lds, wid, lane); S.done(cur); }
#undef PG8_SA
#undef PG8_SB
#undef PG8_STAGE
#undef PG8_LDA
#undef PG8_LDB
#undef PG8_MMA
#undef PG8_WAIT_V
#undef PG8_WAIT_L
#undef PG8_BAR
#undef PG8_SCHED
}
}

constexpr int NWAVES = 8, NTHREADS = NWAVES * 64;
constexpr int SEQ = 8192, NB = 2, M = NB * SEQ, D = 2048, FF = 5632, NIN = 5632, LW = 1536;
constexpr size_t SEC_K = (size_t)16384 * 1536, SEC_V = (size_t)16384 * 2048, SEC_XB = (size_t)16384 * 2560, SEC_YG = (size_t)16384 * 4096;
constexpr float LN_EPS = 1e-5f, ALPHA = 1.189207115002721f;
constexpr size_t MiB = 1u << 20;
constexpr size_t WS_BAR = 0, WS_CNT = 65536  , WS_LSE = 1 * MiB, WS_SP = 2 * MiB, WS_SLOT = 2 * MiB + 262144  , WS_TS = 4 * MiB - 65536;
constexpr size_t WS_WFGU = 4 * MiB, WS_WFD = 48 * MiB;
constexpr size_t WS_WIN = 70 * MiB, WS_WOUT = 92 * MiB, WS_WPG = 100 * MiB, WS_WPP = 108 * MiB, WS_WRG = 109 * MiB, WS_PB = 111 * MiB;
constexpr size_t WS_XB = 120 * MiB;
constexpr size_t WS_H = 184 * MiB;
constexpr size_t WS_XC = 360 * MiB, WS_LA = 408 * MiB, WS_U = 456 * MiB, WS_END = 504 * MiB;
constexpr int LDS_BYTES = 147456;

#define LAS __attribute__((address_space(3)))
typedef unsigned short bf16;
typedef unsigned v4u __attribute__((ext_vector_type(4)));
typedef unsigned v2u __attribute__((ext_vector_type(2)));
typedef float f32x4 __attribute__((ext_vector_type(4)));
#define LDS_WAIT() asm volatile("s_waitcnt lgkmcnt(0)" ::: "memory")
__device__ __forceinline__ unsigned f2bf(float f) { unsigned u = __builtin_bit_cast(unsigned, f); return (u + 0x7fffu + ((u >> 16) & 1u)) >> 16; }
__device__ __forceinline__ unsigned pk2(float lo, float hi) { return f2bf(lo) | (f2bf(hi) << 16); }
__device__ __forceinline__ float bflo(unsigned w) { return __uint_as_float(w << 16); }
__device__ __forceinline__ float bfhi(unsigned w) { return __uint_as_float(w & 0xffff0000u); }
__device__ __forceinline__ float bf1(bf16 h) { return __uint_as_float((unsigned)h << 16); }
__device__ __forceinline__ float wave_sum(float v) {
#pragma unroll
    for (int o = 1; o < 64; o <<= 1) v += __shfl_xor(v, o);
    return v;
}
__device__ __forceinline__ float wave_max(float v) {
#pragma unroll
    for (int o = 1; o < 64; o <<= 1) v = fmaxf(v, __shfl_xor(v, o));
    return v;
}
__device__ __forceinline__ float gelu_tanh(float x) {
    const float y = 0.7978845608028654f * (x + 0.044715f * x * x * x);
    const float t = 1.0f - 2.0f * __builtin_amdgcn_rcpf(1.0f + __expf(2.0f * y));
    return 0.5f * x * (1.0f + t);
}

struct Args { const float* in[26]; float* out; unsigned char* ws; int ph_lo, ph_hi; };

__device__ __forceinline__ void tr_item(const float* W, int N, int k0, int n0, bf16* WT, int drow0, int ldt, int dcol0, LAS float* scr, int lane, bool nts = false) {
    float tv[32];
#pragma unroll
    for (int i = 0; i < 32; ++i) tv[i] = __builtin_nontemporal_load(&W[(size_t)(k0 + 2 * i + (lane >> 5)) * N + n0 + (lane & 31)]);
#pragma unroll
    for (int i = 0; i < 32; ++i) scr[(2 * i + (lane >> 5)) * 33 + (lane & 31)] = tv[i];
    LDS_WAIT(); asm volatile("" ::: "memory");
    const int c = lane & 7;
#pragma unroll
    for (int j = 0; j < 4; ++j) { const int n = (lane >> 3) + 8 * j; const LAS float* s = scr + (8 * c) * 33 + n;
        v4u o; o.x = pk2(s[0 * 33], s[1 * 33]); o.y = pk2(s[2 * 33], s[3 * 33]); o.z = pk2(s[4 * 33], s[5 * 33]); o.w = pk2(s[6 * 33], s[7 * 33]);
        if (nts) __builtin_nontemporal_store(o, (v4u*)(WT + (size_t)(drow0 + n) * ldt + dcol0 + 8 * c)); else *(v4u*)(WT + (size_t)(drow0 + n) * ldt + dcol0 + 8 * c) = o; }
    LDS_WAIT(); asm volatile("" ::: "memory");
}
__device__ __forceinline__ void tr_matrix_item(const float* W, int K, int N, bf16* WT, int mode, int item, LAS float* scr, int lane, bool nts = false) {
    const int nblk = N / 32, kb = item / nblk, nb = item % nblk, k0 = 64 * kb, n0 = 32 * nb;
    int drow0 = n0; if (mode) drow0 = 256 * (n0 >> 7) + (n0 & 127) + (mode == 2 ? 128 : 0);
    tr_item(W, N, k0, n0, WT, drow0, K, k0, scr, lane, nts);
}
constexpr int IT_FF = (D / 64) * (FF / 32);
__device__ __forceinline__ void convert_ffn(const float* wg, const float* wu, const float* wd, unsigned char* ws, LAS float* scr, int it_lo, int it_hi, int gw, int NGW, int lane, bool late = false) {
    for (int it = it_lo + gw; it < it_hi; it += NGW) {
        int r = it;
        if (r < IT_FF) { tr_matrix_item(wg, D, FF, (bf16*)(ws + WS_WFGU), 1, r, scr, lane, late); continue; } r -= IT_FF;
        if (r < IT_FF) { tr_matrix_item(wu, D, FF, (bf16*)(ws + WS_WFGU), 2, r, scr, lane, late); continue; } r -= IT_FF;
        tr_matrix_item(wd, FF, D, (bf16*)(ws + WS_WFD), 0, r, scr, lane, true);
    }
}
__device__ __forceinline__ void convert_rest(const Args& a, LAS float* scr, int gw, int NGW, int lane) {
    unsigned char* ws = a.ws;
    constexpr int I_IN = IT_FF, I_SQ = (D / 64) * (D / 32), I_PP = (256 / 64) * (D / 32), I_RG = 24 * 8;
    for (int it = gw; it < I_IN + 2 * I_SQ + I_PP + I_RG; it += NGW) {
        int r = it;
        if (r < I_IN) { tr_matrix_item(a.in[8], D, NIN, (bf16*)(ws + WS_WIN), 0, r, scr, lane, true); continue; } r -= I_IN;
        if (r < I_SQ) { tr_matrix_item(a.in[16], D, D, (bf16*)(ws + WS_WOUT), 0, r, scr, lane, true); continue; } r -= I_SQ;
        if (r < I_SQ) { tr_matrix_item(a.in[25], D, D, (bf16*)(ws + WS_WPG), 0, r, scr, lane, true); continue; } r -= I_SQ;
        if (r < I_PP) { tr_matrix_item(a.in[24], 256, D, (bf16*)(ws + WS_WPP), 0, r, scr, lane, true); continue; } r -= I_PP;
        { const int mi = r >> 3, sub = r & 7, gate = mi / 12, g = mi % 12, kb = sub >> 2, nb = sub & 3;
          const float* W = (gate ? a.in[13] : a.in[11]) + (size_t)g * 128 * 128; bf16* WT = (bf16*)(ws + WS_WRG);
          const int drow0 = 256 * g + 128 * gate + 32 * nb;
          tr_item(W, 128, 64 * kb, 32 * nb, WT, drow0, 256, 128 * (g & 1) + 64 * kb, scr, lane);
          const int c = lane & 7;
#pragma unroll
          for (int j = 0; j < 4; ++j) { const int n = (lane >> 3) + 8 * j; *(v4u*)(WT + (size_t)(drow0 + n) * 256 + 128 * ((g & 1) ^ 1) + 64 * kb + 8 * c) = (v4u){0u, 0u, 0u, 0u}; } }
    }
}
__device__ __forceinline__ void cvt_rows(const float* src, bf16* dst, size_t n, int gtid, int gthreads) {
    for (size_t i = (size_t)gtid * 8; i < n; i += (size_t)gthreads * 32) {
        f32x4 a[4], b[4];
#pragma unroll
        for (int k = 0; k < 4; ++k) if (i + (size_t)k * gthreads * 8 < n) { a[k] = __builtin_nontemporal_load((const f32x4*)(src + i + (size_t)k * gthreads * 8)); b[k] = __builtin_nontemporal_load((const f32x4*)(src + i + (size_t)k * gthreads * 8 + 4)); }
#pragma unroll
        for (int k = 0; k < 4; ++k) if (i + (size_t)k * gthreads * 8 < n) *(v4u*)(dst + i + (size_t)k * gthreads * 8) = (v4u){pk2(a[k][0], a[k][1]), pk2(a[k][2], a[k][3]), pk2(b[k][0], b[k][1]), pk2(b[k][2], b[k][3])};
    }
}
__device__ __forceinline__ void ln_rows(float* z, bf16* xb, const float* g, const float* b, int gw, int NGW, int lane) {
    for (int m = gw; m < M; m += NGW) {
        f32x4* zr = (f32x4*)(z + (size_t)m * D) + lane; f32x4 v[8]; float s = 0.f;
#pragma unroll
        for (int j = 0; j < 8; ++j) { v[j] = zr[64 * j]; s += (v[j][0] + v[j][1]) + (v[j][2] + v[j][3]); }
        const float mean = wave_sum(s) * (1.f / D); float s2 = 0.f;
#pragma unroll
        for (int j = 0; j < 8; ++j) { v[j] = v[j] - mean; s2 += (v[j][0] * v[j][0] + v[j][1] * v[j][1]) + (v[j][2] * v[j][2] + v[j][3] * v[j][3]); }
        const float rstd = 1.f / sqrtf(wave_sum(s2) * (1.f / D) + LN_EPS);
        v2u* o8 = (v2u*)(xb + (size_t)m * D) + lane;
#pragma unroll
        for (int j = 0; j < 8; ++j) { const f32x4 gg = *((const f32x4*)g + lane + 64 * j), bb = *((const f32x4*)b + lane + 64 * j);
            const f32x4 y = v[j] * rstd * gg + bb; zr[64 * j] = y; o8[64 * j] = (v2u){pk2(y[0], y[1]), pk2(y[2], y[3])}; }
    }
}
__device__ __forceinline__ void conv_rows(const bf16* proj, const float* cw, const float* cb, bf16* xc, int gtid, int gthreads) {
    for (int it = gtid; it < (M / 4) * (LW / 8); it += gthreads) {
        const int m0 = (it / (LW / 8)) * 4, c8 = (it % (LW / 8)) * 8, t0 = m0 & (SEQ - 1);
        v4u xv[7];
#pragma unroll
        for (int j = 0; j < 7; ++j) xv[j] = (t0 - 3 + j >= 0) ? *(const v4u*)(proj + SEC_XB + (size_t)(m0 - 3 + j) * LW + c8) : (v4u){0u, 0u, 0u, 0u};
        f32x4 w[4][2];
#pragma unroll
        for (int j = 0; j < 4; ++j) { w[j][0] = *(const f32x4*)(cw + j * LW + c8); w[j][1] = *(const f32x4*)(cw + j * LW + c8 + 4); }
        const f32x4 b0 = *(const f32x4*)(cb + c8), b1 = *(const f32x4*)(cb + c8 + 4);
#pragma unroll
        for (int r = 0; r < 4; ++r) { float acc[8] = {b0[0], b0[1], b0[2], b0[3], b1[0], b1[1], b1[2], b1[3]};
#pragma unroll
            for (int j = 0; j < 4; ++j) { const v4u x = xv[r + j];
                acc[0] += w[j][0][0] * bflo(x[0]); acc[1] += w[j][0][1] * bfhi(x[0]); acc[2] += w[j][0][2] * bflo(x[1]); acc[3] += w[j][0][3] * bfhi(x[1]);
                acc[4] += w[j][1][0] * bflo(x[2]); acc[5] += w[j][1][1] * bfhi(x[2]); acc[6] += w[j][1][2] * bflo(x[3]); acc[7] += w[j][1][3] * bfhi(x[3]); }
            *(v4u*)(xc + (size_t)(m0 + r) * LW + c8) = (v4u){pk2(acc[0], acc[1]), pk2(acc[2], acc[3]), pk2(acc[4], acc[5]), pk2(acc[6], acc[7])}; }
    }
}
typedef short s16x8 __attribute__((ext_vector_type(8)));
typedef short s16x4 __attribute__((ext_vector_type(4)));
typedef float f32x16 __attribute__((ext_vector_type(16)));
typedef float f32x2_t __attribute__((ext_vector_type(2))); typedef __bf16 bf16x2_t __attribute__((ext_vector_type(2)));
__device__ __forceinline__ unsigned cvtpk(float lo, float hi) { f32x2_t v = {lo, hi}; bf16x2_t b = __builtin_convertvector(v, bf16x2_t); return __builtin_bit_cast(unsigned, b); }
__device__ __forceinline__ s16x4 vtr(LAS unsigned char* p) { return __builtin_bit_cast(s16x4, __builtin_amdgcn_ds_read_tr16_b64_v4i16((LAS s16x4*)p)); }
__device__ __forceinline__ int crow(int r, int h) { return (r & 3) + 8 * (r >> 2) + 4 * h; }
__device__ __forceinline__ void attn_mfma(bf16* hb, float* lse, LAS unsigned char* lds, int bid_, int G_, int wave, int wsub, int nwv, int lane) {
    LAS unsigned char* kbuf = lds + wave * 16896;
    LAS unsigned char* vbuf = kbuf + 8704;
    const int q32 = lane & 31, hh = lane >> 5;
    const int trl = (4 * hh + ((lane & 15) >> 2)) * 64 + ((lane >> 4) & 1) * 32 + (lane & 3) * 8;
    const int ckey = lane >> 4, cdc = lane & 15;
    const int kst = ckey * 272 + cdc * 16, vst = ((cdc >> 2) * 4) * 512 + ckey * 64 + (cdc & 3) * 16;
    const float C = 0.08838834764831845f * 1.4426950408889634f;
    bf16* Kg = hb + SEC_K; bf16* Vg = hb + SEC_V;
    const int xcd = bid_ & 7, nw = (G_ >> 3) * nwv, lw = (bid_ >> 3) * nwv + wsub;
    for (int u = lw; u < 768 && (bid_ >> 3) < (G_ >> 3); u += nw) {
        const int qg = u & 3, rn = (u >> 2) & 63, g = u >> 8, b = xcd >> 2, hkv = xcd & 3, hq = g * 4 + hkv;
        const int dsh = 2 * g, nbsh = 6 - dsh;
        const int r = rn >> nbsh, n = rn & ((1 << nbsh) - 1);
        const size_t mq = (size_t)b * SEQ + (size_t)(((128 * n + 32 * qg + q32) << dsh) + r);
        bf16* qp = hb + mq * 1536 + hq * 128;
        const int iq = 32 * qg + q32;
        const int kt1 = qg + 4, kt0 = (n == 0) ? 4 : qg;
        v4u kr[8], vr[8];
#define ATT_LOAD(kt) do { const int km0_ = 128 * (n - 1) + 32 * (kt); _Pragma("unroll") for (int i = 0; i < 8; ++i) { \
            const size_t off_ = ((size_t)b * SEQ + (size_t)(((km0_ + ckey + 4 * i) << dsh) + r)) * 512 + hkv * 128 + 8 * cdc; kr[i] = *(const v4u*)(Kg + off_); vr[i] = *(const v4u*)(Vg + off_); } } while (0)
#define ATT_STORE() do { _Pragma("unroll") for (int i = 0; i < 8; ++i) { *(LAS v4u*)(kbuf + kst + i * 1088) = kr[i]; *(LAS v4u*)(vbuf + vst + (i >> 1) * 512 + (i & 1) * 256) = vr[i]; } } while (0)
        unsigned klist = 0; int ntile = 0;
        { const int base5 = (4 * n + qg + 1) % 5;
#pragma unroll
          for (int sg = 0; sg < 5; ++sg) { const int kt = qg + (sg - base5 + 5) % 5; if (kt >= kt0) { klist |= (unsigned)kt << (4 * ntile); ++ntile; } } }
        ATT_LOAD((int)(klist & 15u));
        s16x8 qf[8];
#pragma unroll
        for (int ks = 0; ks < 8; ++ks) qf[ks] = *(const s16x8*)(qp + 16 * ks + 8 * hh);
        f32x16 O[4];
#pragma unroll
        for (int dt = 0; dt < 4; ++dt)
#pragma unroll
            for (int e = 0; e < 16; ++e) O[dt][e] = 0.f;
        float mrun = -INFINITY, lrun = 0.f;
        ATT_STORE();
        for (int ti = 0; ti < ntile; ++ti) {
            const int kt = (int)((klist >> (4 * ti)) & 15u);
            asm volatile("" ::: "memory");
            if (ti + 1 < ntile) ATT_LOAD((int)((klist >> (4 * ti + 4)) & 15u));
            f32x16 S;
#pragma unroll
            for (int e = 0; e < 16; ++e) S[e] = 0.f;
#pragma unroll
            for (int ks = 0; ks < 8; ++ks) { const s16x8 kf = *(const LAS s16x8*)(kbuf + q32 * 272 + 32 * ks + 16 * hh); S = __builtin_amdgcn_mfma_f32_32x32x16_bf16(kf, qf[ks], S, 0, 0, 0); }
            float t[16]; float mt = -INFINITY;
#pragma unroll
            for (int e = 0; e < 16; ++e) t[e] = S[e] * C;
            if (kt == qg || kt == kt1) {
#pragma unroll
                for (int e = 0; e < 16; ++e) { const int j = 32 * kt + crow(e, hh);
                    if (kt == qg ? (j < iq) : (j > iq + 128)) t[e] = -INFINITY; } }
#pragma unroll
            for (int e = 0; e < 16; ++e) mt = fmaxf(mt, t[e]);
            mt = fmaxf(mt, __shfl_xor(mt, 32));
            const float mnew = fmaxf(mrun, mt), alpha = __builtin_amdgcn_exp2f(mrun - mnew);
            float ps = 0.f;
#pragma unroll
            for (int e = 0; e < 16; ++e) { t[e] = __builtin_amdgcn_exp2f(t[e] - mnew); ps += t[e]; }
            lrun = lrun * alpha + ps; mrun = mnew;
            if (ti > 0 && __builtin_amdgcn_ballot_w64(alpha != 1.0f) != 0ull) {
#pragma unroll
                for (int dt = 0; dt < 4; ++dt) O[dt] = O[dt] * alpha; }
            s16x8 pb[2];
#pragma unroll
            for (int s = 0; s < 2; ++s) { v4u w; w[0] = cvtpk(t[8 * s], t[8 * s + 1]); w[1] = cvtpk(t[8 * s + 2], t[8 * s + 3]); w[2] = cvtpk(t[8 * s + 4], t[8 * s + 5]); w[3] = cvtpk(t[8 * s + 6], t[8 * s + 7]); pb[s] = __builtin_bit_cast(s16x8, w); }
#pragma unroll
            for (int dt = 0; dt < 4; ++dt)
#pragma unroll
                for (int s = 0; s < 2; ++s) { const s16x4 lo = vtr(vbuf + (dt * 4 + 2 * s) * 512 + trl), hi = vtr(vbuf + (dt * 4 + 2 * s + 1) * 512 + trl);
                    const s16x8 vf = {lo[0], lo[1], lo[2], lo[3], hi[0], hi[1], hi[2], hi[3]};
                    O[dt] = __builtin_amdgcn_mfma_f32_32x32x16_bf16(vf, pb[s], O[dt], 0, 0, 0); }
            asm volatile("" ::: "memory");
            if (ti + 1 < ntile) ATT_STORE();
        }
#undef ATT_LOAD
#undef ATT_STORE
        const float ltot = lrun + __shfl_xor(lrun, 32), inv = 1.0f / ltot;
#pragma unroll
        for (int dt = 0; dt < 4; ++dt)
#pragma unroll
            for (int rg = 0; rg < 4; ++rg) { const int d0 = 32 * dt + 8 * rg + 4 * hh;
                *(v2u*)(qp + d0) = (v2u){cvtpk(O[dt][4 * rg] * inv, O[dt][4 * rg + 1] * inv), cvtpk(O[dt][4 * rg + 2] * inv, O[dt][4 * rg + 3] * inv)}; }
        if (hh == 0) lse[mq * 12 + hq] = (mrun + __builtin_amdgcn_logf(ltot)) * 0.6931471805599453f;
    }
}
__device__ __forceinline__ void merge_rows(const bf16* proj, const float* lse, bf16* cat, int gtid, int gthreads) {
    for (int it0 = gtid; it0 < M * 64; it0 += 4 * gthreads) {
        v4u o[4][3]; float l[4][3];
#pragma unroll
        for (int k = 0; k < 4; ++k) { const int it = min(it0 + k * gthreads, M * 64 - 1), m = it >> 6, h = (it >> 4) & 3, c8 = (it & 15) * 8;
            const bf16* qp = proj + (size_t)m * 1536 + h * 128 + c8;
#pragma unroll
            for (int g = 0; g < 3; ++g) { l[k][g] = lse[(size_t)m * 12 + 4 * g + h]; o[k][g] = *(const v4u*)(qp + 512 * g); } }
#pragma unroll
        for (int k = 0; k < 4; ++k) { const int it = it0 + k * gthreads, m = it >> 6, h = (it >> 4) & 3, c8 = (it & 15) * 8; if (it >= M * 64) break;
            const float mx = fmaxf(fmaxf(l[k][0], l[k][1]), l[k][2]); float w0 = __expf(l[k][0] - mx), w1 = __expf(l[k][1] - mx), w2 = __expf(l[k][2] - mx);
            const float inv = 1.0f / (w0 + w1 + w2); w0 *= inv; w1 *= inv; w2 *= inv;
            v4u r;
#pragma unroll
            for (int e = 0; e < 4; ++e) r[e] = cvtpk(w0 * bflo(o[k][0][e]) + w1 * bflo(o[k][1][e]) + w2 * bflo(o[k][2][e]), w0 * bfhi(o[k][0][e]) + w1 * bfhi(o[k][1][e]) + w2 * bfhi(o[k][2][e]));
            *(v4u*)(cat + (((size_t)((m >> 13) * 128 + h * 8 + (c8 >> 4)) * SEQ + (m & (SEQ - 1))) * 16 + (c8 & 15))) = r; }
    }
}
__device__ __forceinline__ void scan_items(const bf16* ca, const bf16* uu, const bf16* yg, bf16* cat, LAS float* sm, int G, int bid, int tid, unsigned long long* tsp) {
    const int half = tid & 1, sl = tid >> 1, ce = half * 8;
    LAS float* sP = sm; LAS float* sH = sm + 4096; LAS float* gP = sm + 8192; LAS float* gH = sm + 8192 + 512;
    const int slot = bid >> 3, nslot = G >> 3;
    for (int it_ = slot; it_ < 24; it_ += nslot) {
        const int item = (bid & 7) * 24 + it_;
        const int b = item / (LW / 16), cb = item % (LW / 16);
        const size_t o0 = ((size_t)item * SEQ + sl * 32) * 16 + ce;
        const bf16* cp = ca + o0; const bf16* up = uu + o0; const bf16* yp = yg + o0;
        float P[8], H[8];
#pragma unroll
        for (int e = 0; e < 8; ++e) { P[e] = 1.f; H[e] = 0.f; }
#pragma unroll 8
        for (int t = 0; t < 32; ++t) { const v4u cv = *(const v4u*)(cp + t * 16), uv = *(const v4u*)(up + t * 16);
#pragma unroll
            for (int e = 0; e < 4; ++e) { const float a0 = 1.0f - bflo(cv[e]), a1 = 1.0f - bfhi(cv[e]); H[2 * e] = a0 * H[2 * e] + bflo(uv[e]); H[2 * e + 1] = a1 * H[2 * e + 1] + bfhi(uv[e]); P[2 * e] *= a0; P[2 * e + 1] *= a1; } }
#pragma unroll
        for (int e = 0; e < 8; ++e) { sP[sl * 16 + ce + e] = P[e]; sH[sl * 16 + ce + e] = H[e]; }
        __syncthreads();
        { const int ch = tid & 15, grp = tid >> 4; float p = 1.f, h = 0.f;
#pragma unroll
          for (int k = 0; k < 8; ++k) { const float pp = sP[(grp * 8 + k) * 16 + ch]; h = pp * h + sH[(grp * 8 + k) * 16 + ch]; p *= pp; }
          gP[grp * 16 + ch] = p; gH[grp * 16 + ch] = h; }
        __syncthreads();
        float h[8];
#pragma unroll
        for (int e = 0; e < 8; ++e) h[e] = 0.f;
        const int grp = sl >> 3;
        for (int gg = 0; gg < grp; ++gg)
#pragma unroll
            for (int e = 0; e < 8; ++e) h[e] = gP[gg * 16 + ce + e] * h[e] + gH[gg * 16 + ce + e];
        for (int s2 = grp * 8; s2 < sl; ++s2)
#pragma unroll
            for (int e = 0; e < 8; ++e) h[e] = sP[s2 * 16 + ce + e] * h[e] + sH[s2 * 16 + ce + e];
        const size_t m0 = (size_t)b * SEQ + sl * 32;
        if (tsp && bid == 0 && tid == 0) tsp[24] = __builtin_amdgcn_s_memrealtime();
#pragma unroll 8
        for (int t = 0; t < 32; ++t) { const v4u cv = *(const v4u*)(cp + t * 16), uv = *(const v4u*)(up + t * 16), yv = *(const v4u*)(yp + t * 16);
            v4u o;
#pragma unroll
            for (int e = 0; e < 4; ++e) { h[2 * e] = (1.0f - bflo(cv[e])) * h[2 * e] + bflo(uv[e]); h[2 * e + 1] = (1.0f - bfhi(cv[e])) * h[2 * e + 1] + bfhi(uv[e]);
                o[e] = cvtpk(h[2 * e] * bflo(yv[e]), h[2 * e + 1] * bfhi(yv[e])); }
            *(v4u*)(cat + (((size_t)(b * 128 + 32 + cb) * SEQ + sl * 32 + t) * 16 + ce)) = o; }
        __syncthreads();
    }
}

__device__ __forceinline__ void grid_bar(unsigned* cnt, unsigned target) {
    asm volatile("s_waitcnt vmcnt(0)" ::: "memory");
    __syncthreads();
    if (threadIdx.x == 0) {
        __builtin_amdgcn_fence(__ATOMIC_RELEASE, "agent");
        __hip_atomic_fetch_add(cnt, 1u, __ATOMIC_RELAXED, __HIP_MEMORY_SCOPE_AGENT);
        unsigned spins = 0;
        while (__hip_atomic_load(cnt, __ATOMIC_RELAXED, __HIP_MEMORY_SCOPE_AGENT) < target && ++spins < (1u << 24)) __builtin_amdgcn_s_sleep(1);
        __builtin_amdgcn_fence(__ATOMIC_ACQUIRE, "agent");
        asm volatile("s_waitcnt vmcnt(0)" ::: "memory");
    }
    __syncthreads();
}
#ifndef MK_N_LAUNCHES
#define MK_N_LAUNCHES 1
#endif
constexpr int NPHASES = 14;
constexpr int W2_EARLY = 10240;
__global__ void __launch_bounds__(NTHREADS, 2) fwd_kernel(Args a) {
    extern __shared__ __attribute__((aligned(16))) unsigned char lds_raw[];
    LAS unsigned char* lds = (LAS unsigned char*)lds_raw;
    const int G = gridDim.x, bid = blockIdx.x, NGW = G * NWAVES, gthreads = G * NTHREADS;
#define PHASE_VARS int tid = threadIdx.x; asm volatile("" : "+v"(tid)); const int lane = tid & 63, wave = __builtin_amdgcn_readfirstlane(tid >> 6), gw = bid * NWAVES + wave, gtid = bid * NTHREADS + tid; \
    LAS float* scr = (LAS float*)(lds + wave * 16384); (void)lane; (void)gw; (void)gtid; (void)scr;
    unsigned char* ws = a.ws;
    bf16* XB = (bf16*)(ws + WS_XB); bf16* HB = (bf16*)(ws + WS_H); float* PP = (float*)(ws + WS_H);
    bf16* XC = (bf16*)(ws + WS_XC); bf16* LA = (bf16*)(ws + WS_LA); bf16* UU = (bf16*)(ws + WS_U); float* LSE = (float*)(ws + WS_LSE);
    const float* x = a.in[0]; float* out = a.out;
    const int lo = a.ph_lo, hi = a.ph_hi;
#ifndef PHASE_MASK
#define PHASE_MASK 0xffff
#endif
#define IN(k) (((PHASE_MASK >> (k)) & 1) && lo <= (k) && (k) < hi)
#ifdef PROBE_K
#define SCAN_TSP ((unsigned long long*)(ws + WS_TS))
#define STAMP(k) do { if (bid == 0 && threadIdx.x == 0) ((unsigned long long*)(ws + WS_TS))[(k) + 1] = __builtin_amdgcn_s_memrealtime(); } while (0)
#else
#define SCAN_TSP ((unsigned long long*)nullptr)
#define STAMP(k) do { } while (0)
#endif
#define SEAM(k) do { if (hi > (k) + 1) { if ((k) == 0 || MK_N_LAUNCHES != 1) cg::this_grid().sync(); else grid_bar((unsigned*)(ws + WS_BAR), (++nbar) * (unsigned)G); } STAMP(k); } while (0)
    typedef pg8::StaticOrder SO;
    unsigned nbar = 0;
    if (bid == 0) for (int i = threadIdx.x; i < 3 * 64 * 64; i += NTHREADS) ((unsigned*)(ws + WS_CNT))[i] = 0u;
    if (bid == 0 && threadIdx.x == 0) __hip_atomic_store((unsigned*)(ws + WS_BAR), 0u, __ATOMIC_RELAXED, __HIP_MEMORY_SCOPE_AGENT);
    STAMP(-1);
    if (IN(0)) {
        PHASE_VARS
        convert_ffn(a.in[3], a.in[4], a.in[5], ws, scr, 0, 3 * IT_FF, gw, NGW, lane);
        convert_rest(a, scr, gw, NGW, lane);
        cvt_rows(x, XB, (size_t)M * D, gtid, gthreads);
        cvt_rows(a.in[1], (bf16*)(ws + WS_PB), (size_t)M * 256, gtid, gthreads);
        if (gtid < LW) ((float*)(ws + WS_SP))[gtid] = -8.0f * log1pf(expf(-a.in[15][gtid]));
        __syncthreads(); SEAM(0);
    }
    if (IN(1)) {
        PHASE_VARS
        pg8::Gemm g{XB, (const bf16*)(ws + WS_WFGU), M, 2 * FF, D, D, 0, 0}; SO S; S.init(M, 2 * FF, G, bid);
        pg8::EpiSwiglu E{HB, FF};
        pg8::gemm_phase<pg8::EpiSwiglu, SO, true, true>(lds, g, S, E);
        SEAM(1);
    }
    if (IN(2)) {
        PHASE_VARS
        pg8::Gemm g{HB, (const bf16*)(ws + WS_WFD), M, D, FF, FF, 0, 2}; SO S; S.init(M, D, G, bid);
        pg8::EpiResLn<false> E{x, nullptr, out, XB, D, ALPHA, 0.5f, a.in[6], a.in[7], (unsigned long long*)(ws + WS_SLOT), (unsigned*)(ws + WS_CNT), lds + 131072};
        pg8::gemm_phase<pg8::EpiResLn<false>, SO, false, true>(lds, g, S, E);
        SEAM(2);
    }
    if (IN(4)) {
        PHASE_VARS
        pg8::Gemm g{XB, (const bf16*)(ws + WS_WIN), M, NIN, D, D, 0, 0}; SO S; S.init(M, NIN, G, bid);
        pg8::EpiInProj E{HB, (const int*)a.in[2]};
        pg8::gemm_phase<pg8::EpiInProj, SO, true, true>(lds, g, S, E);
        if (5 * G + bid >= (M / 256) * (NIN / 256)) { __syncthreads(); const int first = (M / 256) * (NIN / 256) - 5 * G; convert_ffn(a.in[19], a.in[20], a.in[21], ws, scr, 0, W2_EARLY, (bid - first) * NWAVES + wave, (G - first) * NWAVES, lane, true); __syncthreads(); }
        SEAM(4);
    }
    if (IN(5)) {
        PHASE_VARS
        if (wave < 4) {
            conv_rows(HB, a.in[9], a.in[10], XC, bid * 256 + tid, G * 256);
            convert_ffn(a.in[19], a.in[20], a.in[21], ws, (LAS float*)(lds + wave * 16896), W2_EARLY, 3 * IT_FF, bid * 4 + wave, G * 4, lane, true);
        } else {
            attn_mfma(HB, LSE, lds, bid, G, wave, wave - 4, 4, lane);
        }
        __syncthreads();
        SEAM(5);
    }
    if (IN(6)) {
        PHASE_VARS
        pg8::Gemm g{XC, (const bf16*)(ws + WS_WRG), M, 3072, 256, LW, 256, 0}; SO S; S.init(M, 3072, G, bid);
        pg8::EpiLru E{XC, LA, UU, a.in[12], a.in[14], (const float*)(ws + WS_SP)};
        pg8::gemm_phase<pg8::EpiLru, SO, true, true>(lds, g, S, E);
        __syncthreads();
        SEAM(6);
    }
    if (IN(7)) {
        PHASE_VARS
        __syncthreads();
        scan_items(LA, UU, HB + SEC_YG, HB + SEC_K, (LAS float*)lds, G, bid, tid, SCAN_TSP);
        merge_rows(HB, LSE, HB + SEC_K, gtid, gthreads);
        SEAM(7);
    }
    if (IN(8)) {
        PHASE_VARS
        pg8::Gemm g{HB + SEC_K, (const bf16*)(ws + WS_WOUT), M, D, D, D, 0, 1}; SO S; S.init(M, D, G, bid);
        pg8::EpiResLn<true> E{nullptr, XB, out, XB, D, ALPHA, 1.0f, a.in[17], a.in[18], (unsigned long long*)(ws + WS_SLOT + 524288), (unsigned*)(ws + WS_CNT) + 4096, lds + 131072};
        pg8::gemm_phase<pg8::EpiResLn<true>, SO, false, true>(lds, g, S, E);
        SEAM(8);
    }
    if (IN(10)) {
        PHASE_VARS
        pg8::Gemm g{XB, (const bf16*)(ws + WS_WFGU), M, 2 * FF, D, D, 0, 0}; SO S; S.init(M, 2 * FF, G, bid);
        pg8::EpiSwiglu E{HB, FF};
        pg8::gemm_phase<pg8::EpiSwiglu, SO, true, true>(lds, g, S, E);
        SEAM(10);
    }
    if (IN(11)) {
        PHASE_VARS
        pg8::Gemm g{HB, (const bf16*)(ws + WS_WFD), M, D, FF, FF, 0, 2}; SO S; S.init(M, D, G, bid);
        pg8::EpiResLn<true> E{nullptr, XB, out, XB, D, ALPHA, 0.5f, a.in[22], a.in[23], (unsigned long long*)(ws + WS_SLOT + 2 * 524288), (unsigned*)(ws + WS_CNT) + 2 * 4096, lds + 131072};
        pg8::gemm_phase<pg8::EpiResLn<true>, SO, false, true>(lds, g, S, E);
        SEAM(11);
    }
    if (IN(13)) {
        PHASE_VARS
        { pg8::Gemm g{(const bf16*)(ws + WS_PB), (const bf16*)(ws + WS_WPP), M, D, 256, 256, 0, 0}; SO S; S.init(M, D, G, bid);
          pg8::EpiBf16 E{HB, D};
          pg8::gemm_phase<pg8::EpiBf16, SO, true, true>(lds, g, S, E); __syncthreads(); __builtin_amdgcn_fence(__ATOMIC_ACQUIRE, "agent"); __syncthreads(); }
        pg8::Gemm g{XB, (const bf16*)(ws + WS_WPG), M, D, D, D, 0, 0}; SO S; S.init(M, D, G, bid);
        pg8::EpiPle E{XB, out, HB, D};
        pg8::gemm_phase<pg8::EpiPle, SO, true, true>(lds, g, S, E);
    }
#ifdef PROBE_K
    cg::this_grid().sync();
    if (bid == 0) { const unsigned long long* ts = (const unsigned long long*)(ws + WS_TS); const int n = (int)((ts[PROBE_K + 1] - ts[PROBE_K0]) / 100ull);
        for (int i = threadIdx.x; i < n; i += NTHREADS) out[(size_t)i * 4099 + 7] += 0.0625f; }
#endif
#undef IN
#undef SEAM
}

extern "C" void kernel_launch(void* const* d_in, const int* in_sizes, int n_in, void* d_out, int out_size, void* d_ws, size_t ws_size, hipStream_t stream) {
    static int grid = 0;
    if (grid == 0) {
        if (n_in != 26 || out_size != M * D || ws_size < WS_END) { fprintf(stderr, "kernel_launch: unexpected problem (n_in %d, out %d, ws %zu)\n", n_in, out_size, ws_size); grid = -1; return; }
        int dev = 0, cus = 0, per_cu = 0;
        (void)hipGetDevice(&dev); (void)hipDeviceGetAttribute(&cus, hipDeviceAttributeMultiprocessorCount, dev);
        if (hipFuncSetAttribute((const void*)fwd_kernel, hipFuncAttributeMaxDynamicSharedMemorySize, LDS_BYTES) != hipSuccess) { fprintf(stderr, "kernel_launch: hipFuncSetAttribute failed\n"); grid = -1; return; }
        if (hipOccupancyMaxActiveBlocksPerMultiprocessor(&per_cu, (const void*)fwd_kernel, NTHREADS, LDS_BYTES) != hipSuccess || per_cu < 1) { fprintf(stderr, "kernel_launch: occupancy query says %d\n", per_cu); per_cu = 1; }
        (void)hipGetLastError();
        grid = cus * 1;
        if (grid != 256) { fprintf(stderr, "kernel_launch: built for a 256-CU device (fused LayerNorm epilogues need 256 workgroups), got %d\n", grid); grid = -1; return; }
    }
    if (grid < 0) return;
    Args a{};
    for (int i = 0; i < 26; ++i) a.in[i] = (const float*)d_in[i];
    a.out = (float*)d_out; a.ws = (unsigned char*)d_ws;
#if MK_N_LAUNCHES == 1
    a.ph_lo = 0; a.ph_hi = NPHASES;
    void* args[] = {&a};
    hipError_t e = hipLaunchCooperativeKernel((const void*)fwd_kernel, dim3(grid), dim3(NTHREADS), args, LDS_BYTES, stream);
    if (e != hipSuccess) fprintf(stderr, "cooperative launch failed: %s (grid %d)\n", hipGetErrorString(e), grid);
#else
    for (int p = 0; p < NPHASES; ++p) { a.ph_lo = p; a.ph_hi = p + 1; hipLaunchKernelGGL(fwd_kernel, dim3(grid), dim3(NTHREADS), LDS_BYTES, stream, a); }
#endif
}
```
